# Optimizing an MI355X kernel written in HIP

```python
import math
import jax, jax.numpy as jnp
from jax import lax
import numpy as np

D_MODEL = 1024
BATCH = 32
SEQ = 256
DEPTH = 4
DEC_BATCH = 8
DEC_SEQ = 4096
PAST_LEN = 512

GRID_W = 64
EPS = 1e-6
CHUNK = 64
SHORT_CONV = 3
N_EVEN = (DEPTH + 1) // 2
N_ODD = DEPTH // 2
HY_W = D_MODEL // 2
HY_ORDER = 2
HY_EMB = 33
HY_BANDS = (HY_EMB - 1) // 2
HY_FILTER_HIDDEN = 64
HY_TARGET = 1e-2
HY_FAST = 0.3
HY_SLOW = 1.5
M_HEADS = 4
M_DH = (D_MODEL // 2) // M_HEADS
M_W = M_HEADS * M_DH
EV_CONV = 3 * HY_W + 2 * M_W
EV_PROJ = EV_CONV + 2 * M_W + 4 * M_HEADS
EV_OUT_IN = HY_W + M_W
SSD_INNER = 2 * D_MODEL
SSD_HEADDIM = 64
SSD_HEADS = SSD_INNER // SSD_HEADDIM
SSD_GROUPS = 8
SSD_HPG = SSD_HEADS // SSD_GROUPS
SSD_STATE = 128
SSD_CONV_DIM = SSD_INNER + 2 * SSD_GROUPS * SSD_STATE
OD_PROJ = SSD_INNER + SSD_CONV_DIM + 2 * SSD_HEADS
FFN_HIDDEN = -(-8 * D_MODEL // (3 * 256)) * 256

kernel_name = "hybrid_hyena_mlstm_ssd_prefix_diffusion_step"


def _rmsnorm(x, g):
    xf = x.astype(jnp.float32)
    y = xf * lax.rsqrt(jnp.mean(xf * xf, axis=-1, keepdims=True) + EPS)
    return (y * g.astype(jnp.float32)).astype(x.dtype)


def _short_conv(u, w, b):
    L = u.shape[1]
    pad = SHORT_CONV // 2
    up = jnp.pad(u, ((0, 0), (pad, SHORT_CONV - 1 - pad), (0, 0)))
    y = b
    for j in range(SHORT_CONV):
        y = y + up[:, j:j + L] * w[j]
    return y


def _to_colmajor(x):
    B, L, C = x.shape
    rows = L // GRID_W
    return x.reshape(B, rows, GRID_W, C).swapaxes(1, 2).reshape(B, L, C)


def _from_colmajor(x):
    B, L, C = x.shape
    rows = L // GRID_W
    return x.reshape(B, GRID_W, rows, C).swapaxes(1, 2).reshape(B, L, C)


def _chunks(t):
    B, L = t.shape[:2]
    return t.reshape((B, L // CHUNK, CHUNK) + t.shape[2:]).swapaxes(0, 1)


def _unchunk(t):
    t = t.swapaxes(0, 1)
    return t.reshape((t.shape[0], t.shape[1] * t.shape[2]) + t.shape[3:])


def _hyena_spectra(L, w1, b1, w2, b2, w3, freq):
    f32 = jnp.float32
    t = jnp.linspace(0.0, 1.0, L, dtype=f32)[:, None]
    ang = (2.0 * math.pi / L) * jnp.arange(L, dtype=f32)[:, None] * \
        jnp.linspace(1e-4, HY_BANDS - 1, HY_BANDS, dtype=f32)[None]
    feats = jnp.concatenate([t, jnp.cos(ang), -jnp.sin(ang)], axis=-1)
    fr = freq.astype(f32)
    h = jnp.sin(fr * (feats @ w1.astype(f32) + b1.astype(f32)))
    h = jnp.sin(fr * (h @ w2.astype(f32) + b2.astype(f32)))
    h = (h @ w3.astype(f32)).reshape(L, 2, HY_ORDER, HY_W)
    deltas = jnp.abs(jnp.linspace(math.log(HY_TARGET) / HY_SLOW, math.log(HY_TARGET) / HY_FAST, HY_W, dtype=f32))
    h = h * jnp.exp(-t * deltas)[:, None, None, :]
    k = jnp.concatenate([h[:, 0], jnp.zeros((1, HY_ORDER, HY_W), f32), h[:0:-1, 1]], axis=0)
    k = k / jnp.sum(jnp.abs(k), axis=0, keepdims=True)
    return jnp.fft.rfft(k, axis=0)


def _hyena(v, x1, x2, w1, b1, w2, b2, w3, freq, bias):
    L = v.shape[1]
    K = _hyena_spectra(L, w1, b1, w2, b2, w3, freq)
    bias = bias.astype(jnp.float32)
    z = v.astype(jnp.float32)
    for o, gate in enumerate((x1, x2)):
        Z = jnp.fft.rfft(z, n=2 * L, axis=1)
        y = jnp.fft.irfft(Z * K[:, o], n=2 * L, axis=1)[:, :L]
        z = gate.astype(jnp.float32) * (y + z * bias[o])
    return z.astype(v.dtype)


def _mlstm_scan(q, k, v, ig, lf, C0, n0, m0):
    mask = jnp.tril(jnp.ones((CHUNK, CHUNK), bool))[None, :, :, None]

    def step(carry, inp):
        C, n, m = carry
        qc, kc, vc, ic, fc = inp
        b = jnp.cumsum(fc, axis=1)
        dlog = jnp.where(mask, b[:, :, None] - b[:, None, :] + ic[:, None, :], -jnp.inf)
        inter = b + m[:, None]
        mt = jnp.maximum(inter, jnp.max(dlog, axis=2))
        w = jnp.exp(dlog - mt[:, :, None])
        a_in = jnp.exp(inter - mt)
        s = jnp.einsum('blhd,bshd->blsh', qc, kc) * w
        num = jnp.einsum('blsh,bshd->blhd', s, vc) + a_in[..., None] * jnp.einsum('blhd,bhde->blhe', qc, C)
        den = jnp.sum(s, axis=2) + a_in * jnp.einsum('blhd,bhd->blh', qc, n)
        h = num / jnp.maximum(jnp.abs(den), jnp.exp(-mt))[..., None]
        m_new = mt[:, -1]
        w_end = jnp.exp(b[:, -1:] - b + ic - m_new[:, None])
        dec = jnp.exp(b[:, -1] + m - m_new)
        kw = kc * w_end[..., None]
        C_new = dec[..., None, None] * C + jnp.einsum('bshd,bshe->bhde', kw, vc)
        n_new = dec[..., None] * n + jnp.sum(kw, axis=1)
        return (C_new, n_new, m_new), h

    (C, n, m), hs = lax.scan(step, (C0, n0, m0),
                             (_chunks(q), _chunks(k), _chunks(v), _chunks(ig), _chunks(lf)))
    return _unchunk(hs), C, n, m


def _mlstm(q, k, v, o, gates, gate_b, norm_g, st):
    f32 = jnp.float32
    B, L, _ = q.shape
    q = q.astype(f32).reshape(B, L, M_HEADS, M_DH)
    k = k.astype(f32).reshape(B, L, M_HEADS, M_DH) * (M_DH ** -0.5)
    v = v.astype(f32).reshape(B, L, M_HEADS, M_DH)
    g = (gates.astype(f32) + gate_b.astype(f32)).reshape(B, L, 4, M_HEADS)
    i_f, lf_f = g[:, :, 0], jax.nn.log_sigmoid(g[:, :, 1])
    i_b, lf_b = g[:, :, 2], jax.nn.log_sigmoid(g[:, :, 3])
    C0, n0, m0 = (s.astype(f32) for s in st)
    hf, Cf, nf, mf = _mlstm_scan(q, k, v, i_f, lf_f, C0[:, 0], n0[:, 0], m0[:, 0])
    fl = lambda t: jnp.flip(t, axis=1)
    hb, Cb, nb, mb = _mlstm_scan(fl(q), fl(k), fl(v), fl(i_b), fl(lf_b), C0[:, 1], n0[:, 1], m0[:, 1])
    h = hf + fl(hb)
    h = h * lax.rsqrt(jnp.mean(h * h, axis=-1, keepdims=True) + EPS) * norm_g.astype(f32).reshape(M_HEADS, M_DH)
    h = jax.nn.sigmoid(o.astype(f32)) * h.reshape(B, L, M_W)
    new_st = (jnp.stack([Cf, Cb], 1), jnp.stack([nf, nb], 1), jnp.stack([mf, mb], 1))
    return h, new_st


def _ssd_scan(x, a, Bm, Cm, S0):
    mask = jnp.tril(jnp.ones((CHUNK, CHUNK), bool))[None, :, :, None, None]

    def step(S, inp):
        xc, ac, bc, cc = inp
        acs = jnp.cumsum(ac, axis=1)
        Lm = jnp.exp(jnp.where(mask, acs[:, :, None] - acs[:, None, :], -jnp.inf))
        cb = jnp.einsum('blgn,bsgn->blsg', cc, bc)
        y = jnp.einsum('blsgr,bsgrp->blgrp', cb[..., None] * Lm, xc) + \
            jnp.einsum('blgn,bgrpn->blgrp', cc, S) * jnp.exp(acs)[..., None]
        dec_end = jnp.exp(acs[:, -1:] - acs)
        S_new = jnp.exp(acs[:, -1])[..., None, None] * S + \
            jnp.einsum('blgn,blgrp->bgrpn', bc, xc * dec_end[..., None])
        return S_new, y

    S, ys = lax.scan(step, S0, (_chunks(x), _chunks(a), _chunks(Bm), _chunks(Cm)))
    return _unchunk(ys), S


def _ssd(z, xbc, dt_pre, dt_bias, A_log, Dskip, norm_g, st):
    f32 = jnp.float32
    B, L, _ = z.shape
    xbc = xbc.astype(f32)
    xs = xbc[..., :SSD_INNER].reshape(B, L, SSD_GROUPS, SSD_HPG, SSD_HEADDIM)
    GN = SSD_GROUPS * SSD_STATE
    Bm = xbc[..., SSD_INNER:SSD_INNER + GN].reshape(B, L, SSD_GROUPS, SSD_STATE)
    Cm = xbc[..., SSD_INNER + GN:].reshape(B, L, SSD_GROUPS, SSD_STATE)
    dt = jax.nn.softplus(dt_pre.astype(f32).reshape(B, L, 2, SSD_HEADS) + dt_bias.astype(f32))
    A = -jnp.exp(A_log.astype(f32))
    S0 = st.astype(f32)
    fl = lambda t: jnp.flip(t, axis=1)
    outs = []
    for d in range(2):
        dtd = dt[:, :, d].reshape(B, L, SSD_GROUPS, SSD_HPG)
        xd = xs * dtd[..., None]
        ad = dtd * A[d].reshape(SSD_GROUPS, SSD_HPG)
        s0 = S0[:, d].reshape(B, SSD_GROUPS, SSD_HPG, SSD_HEADDIM, SSD_STATE)
        if d == 0:
            y, S = _ssd_scan(xd, ad, Bm, Cm, s0)
        else:
            y, S = _ssd_scan(fl(xd), fl(ad), fl(Bm), fl(Cm), s0)
            y = fl(y)
        outs.append((y, S.reshape(B, SSD_HEADS, SSD_HEADDIM, SSD_STATE)))
    y = outs[0][0] + outs[1][0] + Dskip.astype(f32).reshape(SSD_GROUPS, SSD_HPG)[..., None] * xs
    y = y.reshape(B, L, SSD_INNER) * jax.nn.silu(z.astype(f32))
    y = y * lax.rsqrt(jnp.mean(y * y, axis=-1, keepdims=True) + EPS) * norm_g.astype(f32)
    return y, jnp.stack([outs[0][1], outs[1][1]], 1)


def _even_mixer(h, e, st, P):
    proj = h @ P['ev_in_w'][e]
    cv = _short_conv(proj[..., :EV_CONV], P['ev_conv_w'][e], P['ev_conv_b'][e])
    hv, hx1, hx2 = cv[..., :HY_W], cv[..., HY_W:2 * HY_W], cv[..., 2 * HY_W:3 * HY_W]
    o0 = 3 * HY_W
    mq = jax.nn.silu(cv[..., o0:o0 + M_W])
    mk = jax.nn.silu(cv[..., o0 + M_W:o0 + 2 * M_W])
    mv = proj[..., EV_CONV:EV_CONV + M_W]
    mo = proj[..., EV_CONV + M_W:EV_CONV + 2 * M_W]
    mg = proj[..., EV_CONV + 2 * M_W:]
    y_hy = _hyena(hv, hx1, hx2, P['hy_w1'][e], P['hy_b1'][e], P['hy_w2'][e], P['hy_b2'][e],
                  P['hy_w3'][e], P['hy_freq'][e], P['hy_bias'][e])
    y_m, new_st = _mlstm(mq, mk, mv, mo, mg, P['m_gate_b'][e], P['m_norm_g'][e], st)
    y = jnp.concatenate([y_hy.astype(h.dtype), y_m.astype(h.dtype)], axis=-1)
    return y @ P['ev_out_w'][e], new_st


def _odd_mixer(h, o, st, P):
    proj = h @ P['od_in_w'][o]
    z = proj[..., :SSD_INNER]
    xbc = jax.nn.silu(_short_conv(proj[..., SSD_INNER:SSD_INNER + SSD_CONV_DIM], P['od_conv_w'][o], P['od_conv_b'][o]))
    dt_pre = proj[..., SSD_INNER + SSD_CONV_DIM:]
    y, new_st = _ssd(z, xbc, dt_pre, P['ssd_dt_bias'][o], P['ssd_A_log'][o], P['ssd_D'][o], P['ssd_norm_g'][o], st)
    return y.astype(h.dtype) @ P['od_out_w'][o], new_st


def _trunk(x, cond, init_states, grid, P):
    states_out = []
    for l in range(DEPTH):
        mod = (jax.nn.silu(cond) @ P['mod_w'][l] + P['mod_b'][l])[:, None, :]
        sh1, sc1, g1, sh2, sc2, g2 = jnp.split(mod, 6, axis=-1)
        h = _rmsnorm(x, P['norm1_g'][l]) * (1 + sc1) + sh1
        colmajor = grid and (l // 2) % 2 == 1
        if colmajor:
            h = _to_colmajor(h)
        if l % 2 == 0:
            out, st = _even_mixer(h, l // 2, init_states[l], P)
        else:
            out, st = _odd_mixer(h, l // 2, init_states[l], P)
        if colmajor:
            out = _from_colmajor(out)
        x = x + g1 * out
        h = _rmsnorm(x, P['norm2_g'][l]) * (1 + sc2) + sh2
        ff = (jax.nn.silu(h @ P['ffn_w1'][l]) * (h @ P['ffn_w3'][l])) @ P['ffn_w2'][l]
        x = x + g2 * ff
        states_out.append(st)
    return _rmsnorm(x, P['final_g']), states_out


def setup_inputs(seed: int = 0) -> dict:
    key = jax.random.key(seed)
    ks = iter(jax.random.split(key, 64))
    nrm = lambda shape, s: s * jax.random.normal(next(ks), shape, jnp.float32)
    D = D_MODEL
    inp = {}
    inp['x_prompt'] = nrm((BATCH, SEQ, D), 1.0)
    inp['x_sample'] = nrm((DEC_BATCH, DEC_SEQ, D), 1.0)
    inp['state_mlstm_C'] = nrm((DEC_BATCH, N_EVEN, 2, M_HEADS, M_DH, M_DH), 0.1)
    inp['state_mlstm_n'] = nrm((DEC_BATCH, N_EVEN, 2, M_HEADS, M_DH), 0.1)
    inp['state_mlstm_m'] = nrm((DEC_BATCH, N_EVEN, 2, M_HEADS), 1.0)
    inp['state_ssd'] = nrm((DEC_BATCH, N_ODD, 2, SSD_HEADS, SSD_HEADDIM, SSD_STATE), 0.1)
    inp['c'] = nrm((DEC_BATCH, D), 1.0)
    inp['c_ctx'] = nrm((D,), 1.0)
    inp['mod_w'] = nrm((DEPTH, D, 6 * D), 0.5 * D ** -0.5)
    inp['mod_b'] = nrm((DEPTH, 6 * D), 0.02)
    inp['norm1_g'] = 1.0 + nrm((DEPTH, D), 0.02)
    inp['norm2_g'] = 1.0 + nrm((DEPTH, D), 0.02)
    inp['ffn_w1'] = nrm((DEPTH, D, FFN_HIDDEN), D ** -0.5)
    inp['ffn_w3'] = nrm((DEPTH, D, FFN_HIDDEN), D ** -0.5)
    inp['ffn_w2'] = nrm((DEPTH, FFN_HIDDEN, D), FFN_HIDDEN ** -0.5)
    inp['final_g'] = 1.0 + nrm((D,), 0.02)
    inp['ev_in_w'] = nrm((N_EVEN, D, EV_PROJ), D ** -0.5)
    inp['ev_conv_w'] = nrm((N_EVEN, SHORT_CONV, EV_CONV), SHORT_CONV ** -0.5)
    inp['ev_conv_b'] = nrm((N_EVEN, EV_CONV), 0.02)
    inp['hy_w1'] = nrm((N_EVEN, HY_EMB, HY_FILTER_HIDDEN), HY_EMB ** -0.5)
    inp['hy_b1'] = nrm((N_EVEN, HY_FILTER_HIDDEN), 0.1)
    inp['hy_w2'] = nrm((N_EVEN, HY_FILTER_HIDDEN, HY_FILTER_HIDDEN), HY_FILTER_HIDDEN ** -0.5)
    inp['hy_b2'] = nrm((N_EVEN, HY_FILTER_HIDDEN), 0.1)
    inp['hy_w3'] = nrm((N_EVEN, HY_FILTER_HIDDEN, 2 * HY_ORDER * HY_W), HY_FILTER_HIDDEN ** -0.5)
    inp['hy_freq'] = 1.0 + nrm((N_EVEN, HY_FILTER_HIDDEN), 0.02)
    inp['hy_bias'] = nrm((N_EVEN, HY_ORDER, HY_W), 0.5)
    ib = nrm((N_EVEN, 2, M_HEADS), 0.1)
    fb = jnp.linspace(3.0, 6.0, M_HEADS, dtype=jnp.float32) + nrm((N_EVEN, 2, M_HEADS), 0.1)
    inp['m_gate_b'] = jnp.stack([ib[:, 0], fb[:, 0], ib[:, 1], fb[:, 1]], axis=1).reshape(N_EVEN, 4 * M_HEADS)
    inp['m_norm_g'] = 1.0 + nrm((N_EVEN, M_W), 0.02)
    inp['ev_out_w'] = nrm((N_EVEN, EV_OUT_IN, D), EV_OUT_IN ** -0.5)
    inp['od_in_w'] = nrm((N_ODD, D, OD_PROJ), D ** -0.5)
    inp['od_conv_w'] = nrm((N_ODD, SHORT_CONV, SSD_CONV_DIM), SHORT_CONV ** -0.5)
    inp['od_conv_b'] = nrm((N_ODD, SSD_CONV_DIM), 0.02)
    u = jax.random.uniform(next(ks), (N_ODD, 2, SSD_HEADS), jnp.float32)
    dt0 = jnp.exp(u * (math.log(0.1) - math.log(0.001)) + math.log(0.001))
    inp['ssd_dt_bias'] = dt0 + jnp.log(-jnp.expm1(-dt0))
    inp['ssd_A_log'] = jnp.log(jax.random.uniform(next(ks), (N_ODD, 2, SSD_HEADS), jnp.float32, 1.0, 16.0))
    inp['ssd_D'] = 1.0 + nrm((N_ODD, SSD_HEADS), 0.1)
    inp['ssd_norm_g'] = 1.0 + nrm((N_ODD, SSD_INNER), 0.02)
    inp['od_out_w'] = nrm((N_ODD, SSD_INNER, D), SSD_INNER ** -0.5)
    return inp


def reference(x_prompt, x_sample, state_mlstm_C, state_mlstm_n, state_mlstm_m, state_ssd, c, c_ctx,
              mod_w, mod_b, norm1_g, norm2_g, ffn_w1, ffn_w3, ffn_w2, final_g,
              ev_in_w, ev_conv_w, ev_conv_b, hy_w1, hy_b1, hy_w2, hy_b2, hy_w3, hy_freq, hy_bias,
              m_gate_b, m_norm_g, ev_out_w,
              od_in_w, od_conv_w, od_conv_b, ssd_dt_bias, ssd_A_log, ssd_D, ssd_norm_g, od_out_w):
    P = dict(mod_w=mod_w, mod_b=mod_b, norm1_g=norm1_g, norm2_g=norm2_g, ffn_w1=ffn_w1, ffn_w3=ffn_w3,
             ffn_w2=ffn_w2, final_g=final_g, ev_in_w=ev_in_w, ev_conv_w=ev_conv_w, ev_conv_b=ev_conv_b,
             hy_w1=hy_w1, hy_b1=hy_b1, hy_w2=hy_w2, hy_b2=hy_b2, hy_w3=hy_w3, hy_freq=hy_freq, hy_bias=hy_bias,
             m_gate_b=m_gate_b, m_norm_g=m_norm_g, ev_out_w=ev_out_w, od_in_w=od_in_w, od_conv_w=od_conv_w,
             od_conv_b=od_conv_b, ssd_dt_bias=ssd_dt_bias, ssd_A_log=ssd_A_log, ssd_D=ssd_D,
             ssd_norm_g=ssd_norm_g, od_out_w=od_out_w)
    f32 = jnp.float32
    Bp = x_prompt.shape[0]
    ctx_init = []
    for l in range(DEPTH):
        if l % 2 == 0:
            ctx_init.append((jnp.zeros((Bp, 2, M_HEADS, M_DH, M_DH), f32),
                             jnp.zeros((Bp, 2, M_HEADS, M_DH), f32),
                             jnp.zeros((Bp, 2, M_HEADS), f32)))
        else:
            ctx_init.append(jnp.zeros((Bp, 2, SSD_HEADS, SSD_HEADDIM, SSD_STATE), f32))
    y_prompt, ctx_states = _trunk(x_prompt, c_ctx[None, :], ctx_init, False, P)
    lat_init = []
    for l in range(DEPTH):
        if l % 2 == 0:
            e = l // 2
            lat_init.append((state_mlstm_C[:, e], state_mlstm_n[:, e], state_mlstm_m[:, e]))
        else:
            lat_init.append(state_ssd[:, l // 2])
    y_sample, _ = _trunk(x_sample, c, lat_init, True, P)
    dt = x_prompt.dtype
    new_mlstm_C = jnp.stack([ctx_states[l][0] for l in range(0, DEPTH, 2)], axis=1).astype(dt)
    new_mlstm_n = jnp.stack([ctx_states[l][1] for l in range(0, DEPTH, 2)], axis=1).astype(dt)
    new_mlstm_m = jnp.stack([ctx_states[l][2] for l in range(0, DEPTH, 2)], axis=1).astype(dt)
    new_ssd = jnp.stack([ctx_states[l] for l in range(1, DEPTH, 2)], axis=1).astype(dt)
    return (y_prompt, y_sample, new_mlstm_C, new_mlstm_n, new_mlstm_m, new_ssd)
```

```cpp
#include <hip/hip_runtime.h>
#ifndef PROBE
#define PROBE 0
#endif
#define DUP(bit, stmt) do { stmt; if (PROBE & (bit)) { stmt; } } while (0)
#define GSYNC() do { unsigned* bw_ = (unsigned*)(p.ws + WS_BAR); asm volatile("" : "+s"(bw_)); XcdBarrier b_; b_.bar = bw_; b_.x = xb_xcc_id(); b_.st = (volatile LAS unsigned*)(lds + LDS_BYTES - 16); xcd_barrier(b_); if (PROBE & 128) xcd_barrier(b_); } while (0)
#include <hip/hip_cooperative_groups.h>
#include <cstdio>
#include <type_traits>
namespace cg = cooperative_groups;

#define LAS __attribute__((address_space(3)))
typedef unsigned short u16;
typedef short bf16x8 __attribute__((ext_vector_type(8)));
typedef float f32x4 __attribute__((ext_vector_type(4)));
typedef unsigned u32x4 __attribute__((ext_vector_type(4)));
typedef unsigned u32x2 __attribute__((ext_vector_type(2)));
typedef LAS unsigned char* ldsp;

constexpr int D = 1024, NCTX = 8192, NLAT = 32768, NTOK = 40960;
constexpr int NG = 2, CTXG = 4096, LATG = 16384, MG = 20480;
constexpr int EVP = 3600, EVPAD = 3840, EVR = 2064  , ODP = 6208, ODPAD = 6400, FH = 2816;
constexpr int NTHREADS = 512;
constexpr int LDS_BYTES = 160 * 1024;
constexpr float EPS = 1e-6f;

constexpr size_t OUT_C = 41943040ull, OUT_N = 50331648ull, OUT_M = 50397184ull, OUT_SSD = 50397696ull;

constexpr size_t MiB = 1048576ull;
constexpr size_t WS_MODP = 0, WS_MOD = 4 * MiB, WS_NST = 5 * MiB, WS_SC = 7 * MiB, WS_BAR = 7 * MiB + 512 * 1024, WS_MSC = 7 * MiB + 256 * 1024;
constexpr size_t WS_WT = 8 * MiB, WT_IN = WS_WT, WT_OUT = WS_WT + 13 * MiB, WT_F13 = WS_WT + 17 * MiB, WT_F2 = WS_WT + 28 * MiB;
constexpr size_t WS_KERNL = 44 * MiB, WS_KERNC = 77 * MiB;
constexpr size_t EV_H = 80 * MiB, EV_PROJT = 120 * MiB, EV_PROJR = 180 * MiB, EV_Y = 261 * MiB, EV_ST = 341 * MiB;
constexpr size_t EV_RAWL = 421 * MiB, EV_RAWC = 453 * MiB, EV_FSUM = 456 * MiB, EV_YT = 458 * MiB;
constexpr size_t OD_H = 44 * MiB, OD_SEG = 44 * MiB, OD_ZD = 100 * MiB, OD_RAW = 183 * MiB, OD_YF = 183 * MiB, OD_YB = 263 * MiB, OD_ACT = 343 * MiB, OD_DSEG = WS_NST;
constexpr int ZDL = 2112;
constexpr size_t FF_H = 44 * MiB, FF_U = 124 * MiB;

struct Params { const float* in[37]; float* out; unsigned char* ws; };
enum { I_XP = 0, I_XS, I_SC, I_SN, I_SM, I_SSD, I_C, I_CCTX, I_MODW, I_MODB, I_N1G, I_N2G, I_W1, I_W3, I_W2, I_FG, I_EVIN, I_EVCW, I_EVCB,
       I_HW1, I_HB1, I_HW2, I_HB2, I_HW3, I_HFREQ, I_HBIAS, I_MGB, I_MNG, I_EVOUT, I_ODIN, I_ODCW, I_ODCB, I_DTB, I_ALOG, I_SSDD, I_SSDNG, I_ODOUT };

typedef float f32x2 __attribute__((ext_vector_type(2)));
typedef __bf16 bf16x2_t __attribute__((ext_vector_type(2)));
__device__ __forceinline__ u16 f2bf(float f) { const __bf16 h = (__bf16)f; return __builtin_bit_cast(u16, h); }
__device__ __forceinline__ float bf2f(u16 b) { return __uint_as_float(((unsigned)b) << 16); }
__device__ __forceinline__ unsigned pk2(float a, float b) { const f32x2 v = {a, b}; const bf16x2_t r = __builtin_convertvector(v, bf16x2_t); return __builtin_bit_cast(unsigned, r); }
__device__ __forceinline__ float siluf(float x) { return x * __builtin_amdgcn_rcpf(1.0f + __expf(-x)); }
__device__ __forceinline__ float sigmf(float x) { return __builtin_amdgcn_rcpf(1.0f + __expf(-x)); }
__device__ __forceinline__ float softplusf(float x) { return fmaxf(x, 0.f) + __logf(1.0f + __expf(-fabsf(x))); }
__device__ __forceinline__ float logsigf(float x) { return fminf(x, 0.f) - __logf(1.0f + __expf(-fabsf(x))); }
__device__ __forceinline__ void unpack8(u32x4 v, float* f) {
    f[0] = __uint_as_float(v.x << 16); f[1] = __uint_as_float(v.x & 0xffff0000u); f[2] = __uint_as_float(v.y << 16); f[3] = __uint_as_float(v.y & 0xffff0000u);
    f[4] = __uint_as_float(v.z << 16); f[5] = __uint_as_float(v.z & 0xffff0000u); f[6] = __uint_as_float(v.w << 16); f[7] = __uint_as_float(v.w & 0xffff0000u); }
__device__ __forceinline__ void ld8(const u16* p, float* f) { unpack8(*(const u32x4*)p, f); }
__device__ __forceinline__ void ld8f(const float* p, float* f) { f32x4 a = *(const f32x4*)p, b = *(const f32x4*)(p + 4); f[0]=a[0];f[1]=a[1];f[2]=a[2];f[3]=a[3];f[4]=b[0];f[5]=b[1];f[6]=b[2];f[7]=b[3]; }
__device__ __forceinline__ void conv8(const u16* rowp, int ld, bool hasPrev, bool hasNext, const float* w, int cw, const float* b, int ci, float* out) {
    float p0[8], pm[8], pp[8], w0[8], w1[8], w2[8], bb[8];
    ld8(rowp, p0);
    if (hasPrev) ld8(rowp - ld, pm); else { for (int j = 0; j < 8; ++j) pm[j] = 0.f; }
    if (hasNext) ld8(rowp + ld, pp); else { for (int j = 0; j < 8; ++j) pp[j] = 0.f; }
    ld8f(w + ci, w0); ld8f(w + cw + ci, w1); ld8f(w + 2 * cw + ci, w2); ld8f(b + ci, bb);
#pragma unroll
    for (int j = 0; j < 8; ++j) out[j] = bb[j] + w0[j] * pm[j] + w1[j] * p0[j] + w2[j] * pp[j];
}
__device__ __forceinline__ bf16x8 ldfrag(const LAS u16* base, int off) { return *(const LAS bf16x8*)(base + off); }
#define MFMA(a, b, c) __builtin_amdgcn_mfma_f32_16x16x32_bf16((a), (b), (c), 0, 0, 0)

__device__ __forceinline__ int tid_opaque() { int t; asm volatile("v_mov_b32 %0, %1" : "=v"(t) : "v"((int)threadIdx.x)); return t; }
__device__ __forceinline__ int grow_of(int g, int r) { return r < CTXG ? g * CTXG + r : NCTX + g * LATG + (r - CTXG); }
__device__ __forceinline__ int cond_of(int g, int r) { return r < CTXG ? 0 : 1 + g * 4 + ((r - CTXG) >> 12); }
__device__ __forceinline__ int cond_of_global(int gr) { return gr < NCTX ? 0 : 1 + ((gr - NCTX) >> 12); }
__device__ __forceinline__ int perm_row(int r, bool colmajor) {
    if (!colmajor || r < CTXG) return r;
    const int q = r - CTXG, s = q >> 12, i = q & 4095;
    return CTXG + (s << 12) + ((i & 63) << 6) + (i >> 6);
}

namespace pg8 {
constexpr int BM = 256, BK = 64, HALF = 128, HTB = HALF * BK * 2, STAGE_BYTES = 8 * HTB, NXCD = 8, WGM = 8;
__device__ __forceinline__ int lds_byte(int r, int c) { const int st = (r >> 4) * 2 + (c >> 5), rr = r & 15, cc = c & 31, ob = rr * 64 + cc * 2; return st * 1024 + (ob ^ (((ob >> 9) & 1) << 5)); }
__device__ __forceinline__ void stage_rc(int b, int& R, int& C) { const int st = b / 1024, sb = b % 1024, swz = sb ^ (((sb >> 9) & 1) << 5); R = (st >> 1) * 16 + swz / 64; C = (st & 1) * 32 + (swz % 64) / 2; }
struct Unit { int pm, pn; };
struct Gemm { const u16* A; const u16* Bt; int M, N, K; };
struct StaticOrder {
    int nM, nN, nwg, G, c;
    __device__ void init(int M, int N, int G_, int c_) { nM = M / BM; nN = N / BM; nwg = nM * nN; G = G_; c = c_; }
    __device__ bool next(int i, Unit& u) const {
        const long L = (long)i * G + c; if (L >= nwg) return false;
        int wgid = (int)L; { const int q = nwg / NXCD, r = nwg % NXCD, xcd = wgid % NXCD, off = wgid / NXCD; wgid = (xcd < r ? xcd * (q + 1) : r * (q + 1) + (xcd - r) * q) + off; }
        const int nig = WGM * nN, gid = wgid / nig, fm = gid * WGM, gsz = (nM - fm) < WGM ? (nM - fm) : WGM;
        u.pm = fm + ((wgid % nig) % gsz); u.pn = (wgid % nig) / gsz; return true;
    }
};
template <class Epi>
__device__ __forceinline__ void gemm_phase(ldsp lds, const Gemm g, const StaticOrder& S, const Epi& E) {
    const int tid = tid_opaque(), wid = __builtin_amdgcn_readfirstlane(tid >> 6), lane = tid & 63, wr = wid >> 2, wc = wid & 3, fr = lane & 15, fq = lane >> 4;
    const int K = g.K, nt = K / BK;
    unsigned voffA[2];
#pragma unroll
    for (int i = 0; i < 2; ++i) { int R, C; stage_rc(tid * 16 + i * 8192, R, C); voffA[i] = (unsigned)(R * K + C) * 2u; }
    const size_t kstep = (size_t)(BK * 2);
    const size_t hstep = (size_t)HALF * K * 2;
    const size_t tstep = 2 * hstep;
    const unsigned ldsw = (unsigned)wid * 1024u;
    const int aoff = lds_byte(wr * 64 + fr, fq * 8), boff = lds_byte(wc * 32 + fr, fq * 8);
#define PG8_SA(b, h) (((b) * 2 + (h)) * HTB)
#define PG8_SB(b, h) ((4 + (b) * 2 + (h)) * HTB)
#define PG8_STAGE(bufoff, gbase, voff) do { _Pragma("unroll") for (int _i = 0; _i < 2; ++_i) \
        __builtin_amdgcn_global_load_lds((const unsigned*)((const char*)(gbase) + (voff)[_i]), (LAS unsigned*)(lds + (bufoff) + ldsw + _i * 8192), 16, 0, 0); } while (0)
#define PG8_LDA(dst, b, h) do { _Pragma("unroll") for (int m = 0; m < 4; ++m) _Pragma("unroll") for (int k = 0; k < 2; ++k) dst[m][k] = *(const LAS bf16x8*)(lds + PG8_SA(b, h) + aoff + m * 2048 + k * 1024); } while (0)
#define PG8_LDB(dst, b, h) do { _Pragma("unroll") for (int n = 0; n < 2; ++n) _Pragma("unroll") for (int k = 0; k < 2; ++k) dst[n][k] = *(const LAS bf16x8*)(lds + PG8_SB(b, h) + boff + n * 2048 + k * 1024); } while (0)
#define PG8_MMA(ai, bj, At, Bt) do { __builtin_amdgcn_s_setprio(1); _Pragma("unroll") for (int m = 0; m < 4; ++m) _Pragma("unroll") for (int n = 0; n < 2; ++n) _Pragma("unroll") for (int k = 0; k < 2; ++k) \
        acc[ai][bj][m][n] = __builtin_amdgcn_mfma_f32_16x16x32_bf16(Bt[n][k], At[m][k], acc[ai][bj][m][n], 0, 0, 0); __builtin_amdgcn_s_setprio(0); } while (0)
#define PG8_WAIT_V(n) asm volatile("s_waitcnt vmcnt(" #n ")" ::: "memory")
#define PG8_WAIT_L(n) asm volatile("s_waitcnt lgkmcnt(" #n ")" ::: "memory")
#define PG8_BAR __builtin_amdgcn_s_barrier()
#define PG8_SCHED __builtin_amdgcn_sched_barrier(0)
    Unit cur, nxt; int ui = 0;
    if (!S.next(0, cur)) return;
    f32x4 acc[2][2][4][2];
#pragma unroll
    for (int a = 0; a < 2; ++a)
#pragma unroll
        for (int b = 0; b < 2; ++b)
#pragma unroll
            for (int m = 0; m < 4; ++m)
#pragma unroll
                for (int n = 0; n < 2; ++n) acc[a][b][m][n] = (f32x4){0.f, 0.f, 0.f, 0.f};
    bf16x8 At[4][2], B0[2][2], B1[2][2];
    const char* cA = (const char*)g.A + (size_t)cur.pm * tstep; const char* cB = (const char*)g.Bt + (size_t)cur.pn * tstep;
    PG8_STAGE(PG8_SB(0, 0), cB, voffA); PG8_STAGE(PG8_SA(0, 0), cA, voffA); PG8_STAGE(PG8_SB(0, 1), cB + hstep, voffA); PG8_STAGE(PG8_SA(0, 1), cA + hstep, voffA);
    if (wr == 1) PG8_BAR;
    PG8_WAIT_V(4); PG8_BAR;
    PG8_STAGE(PG8_SB(1, 0), cB + kstep, voffA); PG8_STAGE(PG8_SA(1, 0), cA + kstep, voffA); PG8_STAGE(PG8_SB(1, 1), cB + hstep + kstep, voffA);
    PG8_WAIT_V(6); PG8_BAR;
    for (;;) {
        const bool has_next = S.next(ui + 1, nxt);
        const char* nA = has_next ? (const char*)g.A + (size_t)nxt.pm * tstep : cA; const char* nB = has_next ? (const char*)g.Bt + (size_t)nxt.pn * tstep : cB;
        for (int t = 0; t < nt; t += 2) {
            const bool last = (t == nt - 2);
            const char* a1 = cA + (size_t)(t + 1) * kstep;
            const char* a2 = last ? nA : cA + (size_t)(t + 2) * kstep; const char* b2 = last ? nB : cB + (size_t)(t + 2) * kstep;
            const char* a3 = a2 + kstep; const char* b3 = b2 + kstep;
            PG8_LDB(B0, 0, 0); PG8_SCHED; PG8_LDA(At, 0, 0); PG8_STAGE(PG8_SA(1, 1), a1 + hstep, voffA);
            PG8_WAIT_L(8); PG8_BAR; PG8_WAIT_L(0); PG8_MMA(0, 0, At, B0); PG8_BAR; PG8_SCHED;
            PG8_LDB(B1, 0, 1); PG8_STAGE(PG8_SB(0, 0), b2, voffA);
            PG8_BAR; PG8_WAIT_L(0); PG8_MMA(0, 1, At, B1); PG8_BAR;
            PG8_LDA(At, 0, 1); PG8_STAGE(PG8_SA(0, 0), a2, voffA);
            PG8_BAR; PG8_WAIT_L(0); PG8_MMA(1, 0, At, B0); PG8_BAR; PG8_SCHED;
            PG8_STAGE(PG8_SB(0, 1), b2 + hstep, voffA);
            PG8_WAIT_V(6); PG8_BAR; PG8_MMA(1, 1, At, B1); PG8_BAR;
            PG8_LDB(B0, 1, 0); PG8_SCHED; PG8_LDA(At, 1, 0); PG8_STAGE(PG8_SA(0, 1), a2 + hstep, voffA);
            PG8_WAIT_L(8); PG8_BAR; PG8_WAIT_L(0); PG8_MMA(0, 0, At, B0); PG8_BAR; PG8_SCHED;
            PG8_LDB(B1, 1, 1); PG8_STAGE(PG8_SB(1, 0), b3, voffA);
            PG8_BAR; PG8_WAIT_L(0); PG8_MMA(0, 1, At, B1); PG8_BAR;
            PG8_LDA(At, 1, 1); PG8_STAGE(PG8_SA(1, 0), a3, voffA);
            PG8_BAR; PG8_WAIT_L(0); PG8_MMA(1, 0, At, B0); PG8_BAR; PG8_SCHED;
            PG8_STAGE(PG8_SB(1, 1), b3 + hstep, voffA);
            PG8_WAIT_V(6); PG8_BAR; PG8_MMA(1, 1, At, B1); PG8_BAR;
        }
        E(acc, cur, wr, wc, fr, fq);
        if (!has_next) break;
#pragma unroll
        for (int a = 0; a < 2; ++a)
#pragma unroll
            for (int b = 0; b < 2; ++b)
#pragma unroll
                for (int m = 0; m < 4; ++m)
#pragma unroll
                    for (int n = 0; n < 2; ++n) acc[a][b][m][n] = (f32x4){0.f, 0.f, 0.f, 0.f};
        cur = nxt; cA = nA; cB = nB; ++ui;
    }
    PG8_WAIT_V(0);
    if (wr == 0) PG8_BAR;
    PG8_BAR;
#undef PG8_SA
#undef PG8_SB
#undef PG8_STAGE
#undef PG8_LDA
#undef PG8_LDB
#undef PG8_MMA
#undef PG8_WAIT_V
#undef PG8_WAIT_L
#undef PG8_BAR
#undef PG8_SCHED
}
}

typedef const f32x4 (&AccRef)[2][2][4][2];
#define EPI_LOOP_BEGIN \
    _Pragma("unroll") for (int ai = 0; ai < 2; ++ai) _Pragma("unroll") for (int m = 0; m < 4; ++m) { const int row = u.pm * 256 + ai * 128 + wr * 64 + m * 16 + fr;
#define EPI_COLS_BEGIN \
    _Pragma("unroll") for (int bj = 0; bj < 2; ++bj) _Pragma("unroll") for (int n = 0; n < 2; ++n) { const int col = u.pn * 256 + bj * 128 + wc * 32 + n * 16 + 4 * fq; const f32x4 v = acc[ai][bj][m][n];

struct EpiProjEven {
    u16* projT; u16* projR;
    __device__ __forceinline__ void operator()(AccRef acc, const pg8::Unit& u, int wr, int wc, int fr, int fq) const {
        EPI_LOOP_BEGIN EPI_COLS_BEGIN
            if (col < 1536) {
#pragma unroll
                for (int j = 0; j < 4; ++j) projT[(size_t)(col + j) * MG + row] = f2bf(v[j]);
            } else if (col < EVP) {
                u32x2 w; w.x = pk2(v[0], v[1]); w.y = pk2(v[2], v[3]);
                *(u32x2*)(projR + (size_t)row * EVR + (col - 1536)) = w;
            }
        } }
    }
};
struct EpiProjOdd {
    u16* zd; u16* raw;
    __device__ __forceinline__ void operator()(AccRef acc, const pg8::Unit& u, int wr, int wc, int fr, int fq) const {
        EPI_LOOP_BEGIN EPI_COLS_BEGIN
            u32x2 w; w.x = pk2(v[0], v[1]); w.y = pk2(v[2], v[3]);
            if (col < 2048) *(u32x2*)(zd + (size_t)row * ZDL + col) = w;
            else if (col < 6144) *(u32x2*)(raw + (size_t)row * 4096 + (col - 2048)) = w;
            else if (col < ODP) *(u32x2*)(zd + (size_t)row * ZDL + 2048 + (col - 6144)) = w;
        } }
    }
};
struct EpiResid {
    float* x; const float* mod; const float* xp0; const float* xs0; int l, gidx, g; bool colmajor, grouped, first;
    __device__ __forceinline__ void operator()(AccRef acc, const pg8::Unit& u, int wr, int wc, int fr, int fq) const {
        EPI_LOOP_BEGIN
            int grow, cond;
            if (grouped) { const int gg = g + (row >= MG ? 1 : 0); const int r = perm_row(row >= MG ? row - MG : row, colmajor); grow = grow_of(gg, r); cond = cond_of(gg, r); }
            else { grow = row; cond = cond_of_global(row); }
            const float* gp = mod + ((size_t)(l * 9 + cond) * 6 + gidx) * 1024;
            float* xp = x + (size_t)grow * 1024;
            const float* xi = first ? (grow < NCTX ? xp0 + (size_t)grow * 1024 : xs0 + (size_t)(grow - NCTX) * 1024) : xp;
            EPI_COLS_BEGIN
                const f32x4 gt = *(const f32x4*)(gp + col); f32x4 xv = *(const f32x4*)(xi + col);
                xv = xv + gt * v; *(f32x4*)(xp + col) = xv;
            }
        }
    }
};
struct EpiSwiGLU {
    u16* uo;
    __device__ __forceinline__ void operator()(AccRef acc, const pg8::Unit& u, int wr, int wc, int fr, int fq) const {
        EPI_LOOP_BEGIN
#pragma unroll
            for (int bj = 0; bj < 2; ++bj) {
                const int hc = (u.pn * 256 + bj * 128 + wc * 32) / 2 + 4 * fq;
                const f32x4 a = acc[ai][bj][m][0], b = acc[ai][bj][m][1];
                u32x2 w; w.x = pk2(siluf(a[0]) * b[0], siluf(a[1]) * b[1]); w.y = pk2(siluf(a[2]) * b[2], siluf(a[3]) * b[3]);
                *(u32x2*)(uo + (size_t)row * FH + hc) = w;
            }
        }
    }
};

template <class Epi>
__device__ __forceinline__ void run_gemm(ldsp lds, const u16* A, const u16* Bt, int M, int N, int K, const Epi& E) {
    pg8::Gemm g; g.A = A; g.Bt = Bt; g.M = M; g.N = N; g.K = K;
    pg8::StaticOrder S; S.init(M, N, (int)gridDim.x, (int)blockIdx.x);
    pg8::gemm_phase<Epi>(lds, g, S, E);
}

__device__ __forceinline__ void ph_copyx(const Params& p) {
    const f32x4* a = (const f32x4*)p.in[I_XP]; const f32x4* b = (const f32x4*)p.in[I_XS]; f32x4* o = (f32x4*)p.out;
    const size_t n0 = (size_t)NCTX * 256, n1 = (size_t)NTOK * 256;
    for (size_t i = (size_t)blockIdx.x * NTHREADS + tid_opaque(); i < n1; i += (size_t)gridDim.x * NTHREADS) o[i] = i < n0 ? a[i] : b[i - n0];
}
__device__ __forceinline__ void ph_modp(const Params& p, ldsp lds) {
    LAS float* s = (LAS float*)lds;
    float* modp = (float*)(p.ws + WS_MODP);
    const int t = tid_opaque();
    for (int it = blockIdx.x; it < 192; it += gridDim.x) {
        const int l = it / 48, rem = it % 48, cc = rem >> 2, ks = rem & 3;
        __syncthreads();
        for (int idx = t; idx < 9 * 256; idx += NTHREADS) { const int r = idx >> 8, k = idx & 255;
            const float cv = r == 0 ? p.in[I_CCTX][ks * 256 + k] : p.in[I_C][(r - 1) * 1024 + ks * 256 + k]; s[idx] = siluf(cv); }
        __syncthreads();
        const int col = cc * 512 + t;
        float acc[9];
#pragma unroll
        for (int r = 0; r < 9; ++r) acc[r] = 0.f;
        const float* w = p.in[I_MODW] + ((size_t)l * 1024 + ks * 256) * 6144 + col;
#pragma unroll 8
        for (int k = 0; k < 256; ++k) { const float wv = w[(size_t)k * 6144];
#pragma unroll
            for (int r = 0; r < 9; ++r) acc[r] += s[r * 256 + k] * wv; }
#pragma unroll
        for (int r = 0; r < 9; ++r) modp[((size_t)(ks * 4 + l) * 9 + r) * 6144 + col] = acc[r];
    }
}
__device__ __forceinline__ void ph_modfin(const Params& p) {
    const float* modp = (const float*)(p.ws + WS_MODP); float* mod = (float*)(p.ws + WS_MOD);
    for (int idx = blockIdx.x * NTHREADS + tid_opaque(); idx < 221184; idx += gridDim.x * NTHREADS) {
        const int l = idx / (9 * 6144), col = idx % 6144;
        mod[idx] = modp[idx] + modp[221184 + idx] + modp[2 * 221184 + idx] + modp[3 * 221184 + idx] + p.in[I_MODB][l * 6144 + col];
    }
}
__device__ __forceinline__ void ph_wconv(ldsp lds, const float* src, const float* src2, int K, int Nsrc, int Npad, int mode, u16* dst) {
    const int t = tid_opaque(), wid = __builtin_amdgcn_readfirstlane(t >> 6), lane = t & 63, nkt = K / 64, ntiles = (Npad / 64) * nkt;
    for (int it = blockIdx.x; it < ntiles; it += gridDim.x) {
        const int n = (it / nkt) * 64 + 8 * wid + (lane >> 3), k = (it % nkt) * 64 + (lane & 7) * 8;
        const float* sp; int sc; bool valid = true;
        if (mode == 0) { sp = src; sc = n; valid = n < Nsrc; } else { sp = ((n >> 4) & 1) ? src2 : src; sc = (n >> 5) * 16 + (n & 15); }
        float v[8];
#pragma unroll
        for (int j = 0; j < 8; ++j) v[j] = valid ? sp[(size_t)(k + j) * Nsrc + sc] : 0.f;
        u32x4 w; w.x = pk2(v[0], v[1]); w.y = pk2(v[2], v[3]); w.z = pk2(v[4], v[5]); w.w = pk2(v[6], v[7]);
        *(u32x4*)(dst + (size_t)n * K + k) = w;
    }
}
__device__ __forceinline__ void ph_wconv_layer(const Params& p, ldsp lds, int l) {
    const int e = l >> 1;
    if ((l & 1) == 0) {
        ph_wconv(lds, p.in[I_EVIN] + (size_t)e * 1024 * EVP, nullptr, 1024, EVP, EVPAD, 0, (u16*)(p.ws + WT_IN));
        ph_wconv(lds, p.in[I_EVOUT] + (size_t)e * 1024 * 1024, nullptr, 1024, 1024, 1024, 0, (u16*)(p.ws + WT_OUT));
    } else {
        ph_wconv(lds, p.in[I_ODIN] + (size_t)e * 1024 * ODP, nullptr, 1024, ODP, ODPAD, 0, (u16*)(p.ws + WT_IN));
        ph_wconv(lds, p.in[I_ODOUT] + (size_t)e * 2048 * 1024, nullptr, 2048, 1024, 1024, 0, (u16*)(p.ws + WT_OUT));
    }
    ph_wconv(lds, p.in[I_W1] + (size_t)l * 1024 * FH, p.in[I_W3] + (size_t)l * 1024 * FH, 1024, FH, 2 * FH, 1, (u16*)(p.ws + WT_F13));
    ph_wconv(lds, p.in[I_W2] + (size_t)l * FH * 1024, nullptr, FH, 1024, 1024, 0, (u16*)(p.ws + WT_F2));
}

__device__ __forceinline__ void ph_filt_raw(const Params& p, ldsp lds, int e) {
    LAS float* h1 = (LAS float*)lds; LAS float* h2 = h1 + 64 * 65; LAS float* ft = h2 + 64 * 65;
    const int t = tid_opaque(), pos = t & 63, jg = t >> 6;
    const float* w1 = p.in[I_HW1] + e * 33 * 64; const float* b1 = p.in[I_HB1] + e * 64; const float* w2 = p.in[I_HW2] + e * 64 * 64; const float* b2 = p.in[I_HB2] + e * 64;
    const float* w3 = p.in[I_HW3] + (size_t)e * 64 * 2048; const float* fr = p.in[I_HFREQ] + e * 64;
    for (int it4 = blockIdx.x; it4 < 272; it4 += gridDim.x) {
        const int it = it4 >> 2, ci = it4 & 3;
        const bool isc = it < 4; const int L = isc ? 256 : 4096, lb = isc ? it : it - 4;
        float* raw = (float*)(p.ws + (isc ? EV_RAWC : EV_RAWL));
        const float invLm1 = 1.0f / (float)(L - 1);
        __syncthreads();
        {
            const int l = lb * 64 + pos; const float tt = (float)l * invLm1;
            const float w0 = 6.283185307179586f / (float)L;
            if (jg == 0) ft[pos * 33] = tt;
#pragma unroll 1
            for (int bb = 0; bb < 2; ++bb) { const int b = jg * 2 + bb; const float band = 1e-4f + (float)b * ((15.0f - 1e-4f) / 15.0f); const float ang = (w0 * (float)l) * band; ft[pos * 33 + 1 + b] = cosf(ang); ft[pos * 33 + 17 + b] = -sinf(ang); }
        }
        __syncthreads();
        {
#pragma unroll 1
            for (int ju = 0; ju < 8; ++ju) { const int j = jg * 8 + ju; float a = b1[j];
#pragma unroll 11
                for (int i = 0; i < 33; ++i) a += ft[pos * 33 + i] * w1[i * 64 + j];
                h1[pos * 65 + j] = sinf(fr[j] * a); }
        }
        __syncthreads();
        {
#pragma unroll 1
            for (int ju = 0; ju < 8; ++ju) { const int j = jg * 8 + ju; float a = b2[j];
#pragma unroll 16
                for (int i = 0; i < 64; ++i) a += h1[pos * 65 + i] * w2[i * 64 + j];
                h2[pos * 65 + j] = sinf(fr[j] * a); }
        }
        __syncthreads();
        {
            const int col = t + 512 * ci, c = col & 511;
            float wv[64];
#pragma unroll
            for (int k = 0; k < 64; ++k) wv[k] = w3[(size_t)k * 2048 + col];
            const float a0 = -4.605170185988091f / 1.5f, a1 = -4.605170185988091f / 0.3f;
            const float delta = fabsf(a0 + (float)c * ((a1 - a0) / 511.0f));
            float asum = 0.f;
#pragma unroll 1
            for (int q = 0; q < 64; ++q) {
                float a = 0.f;
#pragma unroll
                for (int k = 0; k < 64; ++k) a += h2[q * 65 + k] * wv[k];
                const int lp = lb * 64 + q; const float tp = (float)lp * invLm1;
                const float val = a * expf(-tp * delta);
                raw[(size_t)lp * 2048 + col] = val;
                if (!(lp == 0 && col >= 1024)) asum += fabsf(val);
            }
            ((float*)(p.ws + EV_FSUM))[it * 2048 + col] = asum;
        }
    }
}
__device__ __forceinline__ void ph_filt_norm(const Params& p, ldsp lds) {
    LAS float* tile = (LAS float*)lds; LAS float* inv = tile + 64 * 65;
    const int t = tid_opaque(), cc = t & 63, lg = t >> 6;
    const float* fsum = (const float*)(p.ws + EV_FSUM);
    for (int it = blockIdx.x; it < 544; it += gridDim.x) {
        const bool isc = it >= 512; int o, cb, dir, lc, L;
        if (isc) { const int i2 = it - 512; o = i2 >> 4; cb = (i2 >> 1) & 7; dir = i2 & 1; lc = 0; L = 256; }
        else { o = it >> 8; cb = (it >> 5) & 7; dir = (it >> 4) & 1; lc = it & 15; L = 4096; }
        const int c0 = cb * 64;
        const float* raw = (const float*)(p.ws + (isc ? EV_RAWC : EV_RAWL)); u16* kern = (u16*)(p.ws + (isc ? WS_KERNC : WS_KERNL)); const int RLD = 2 * L + 8;
        if (lc == (isc ? 0 : 15) && t < 64) { u16* im = kern + (size_t)(o * 512 + c0 + t) * 2 * RLD; unsigned zz; asm volatile("v_mov_b32 %0, 0" : "=v"(zz)); const u16 z16 = (u16)zz;
            if (dir == 0) im[0] = z16; else {
#pragma unroll 1
                for (int y = 2 * L - 1; y < RLD; ++y) { if (y >= 2 * L) im[y] = z16; im[RLD + y] = z16; } } }
        __syncthreads();
        if (t < 64) { float sm = 0.f; const int nlb = isc ? 4 : 64, lb0 = isc ? 0 : 4;
            for (int q = 0; q < nlb; ++q) sm += fsum[(lb0 + q) * 2048 + o * 512 + c0 + t] + fsum[(lb0 + q) * 2048 + 1024 + o * 512 + c0 + t];
            inv[t] = 1.0f / sm; }
        __syncthreads();
        for (int l0 = lc * 256; l0 < lc * 256 + 256; l0 += 64) {
#pragma unroll
            for (int i = 0; i < 8; ++i) { const int ll = lg * 8 + i; float v = raw[(size_t)(l0 + ll) * 2048 + dir * 1024 + o * 512 + c0 + cc] * inv[cc]; if (dir == 1 && l0 + ll == 0) v = 0.f; tile[ll * 65 + cc] = v; }
            __syncthreads();
            { const int cw_ = t >> 3, ls = (t & 7) * 8; u16* im = kern + (size_t)(o * 512 + c0 + cw_) * 2 * RLD;
#pragma unroll
              for (int j = 0; j < 8; ++j) { const int l = l0 + ls + j; const u16 hv = f2bf(tile[(ls + j) * 65 + cw_]);
                  if (dir == 0) { im[L - l] = hv; im[RLD + L - l - 1] = hv; }
                  else if (l > 0) { im[L + l] = hv; im[RLD + L + l - 1] = hv; } } }
            __syncthreads();
        }
    }
}

__device__ __forceinline__ void ph_norm(const Params& p, int l, int which, bool grouped, int g, bool colmajor, u16* hdst, int bstart = 0, int bcount = 0, bool dglobal = false) {
    const int t = tid_opaque(), wid = __builtin_amdgcn_readfirstlane(t >> 6), lane = t & 63;
    const float* gam = p.in[which ? I_N2G : I_N1G] + l * 1024; const float* mod = (const float*)(p.ws + WS_MOD);
    const int nrows = grouped ? MG : NTOK;
    if (bcount == 0) bcount = (int)gridDim.x;
    if ((int)blockIdx.x < bstart) return;
    for (int r = ((int)blockIdx.x - bstart) * 8 + wid; r < nrows; r += bcount * 8) {
        int grow, cond, drow;
        if (grouped) { grow = grow_of(g, r); cond = cond_of(g, r); drow = dglobal ? grow : perm_row(r, colmajor); } else { grow = r; cond = cond_of_global(r); drow = r; }
        const float* xp = (l == 0 && which == 0) ? (grow < NCTX ? p.in[I_XP] + (size_t)grow * 1024 : p.in[I_XS] + (size_t)(grow - NCTX) * 1024) : p.out + (size_t)grow * 1024;
        const float* sh = mod + ((size_t)(l * 9 + cond) * 6 + (which ? 3 : 0)) * 1024; const float* sc = sh + 1024;
        f32x4 xv[4]; float ss = 0.f;
#pragma unroll
        for (int i = 0; i < 4; ++i) { xv[i] = *(const f32x4*)(xp + i * 256 + lane * 4); ss += xv[i][0] * xv[i][0] + xv[i][1] * xv[i][1] + xv[i][2] * xv[i][2] + xv[i][3] * xv[i][3]; }
#pragma unroll
        for (int o = 32; o > 0; o >>= 1) ss += __shfl_xor(ss, o);
        const float rstd = rsqrtf(ss * (1.0f / 1024.0f) + EPS);
#pragma unroll
        for (int i = 0; i < 4; ++i) { const int c = i * 256 + lane * 4; const f32x4 gv = *(const f32x4*)(gam + c), sv = *(const f32x4*)(sc + c), hv = *(const f32x4*)(sh + c);
            f32x4 y = xv[i] * rstd * gv * (sv + 1.0f) + hv; u32x2 w; w.x = pk2(y[0], y[1]); w.y = pk2(y[2], y[3]);
            *(u32x2*)(hdst + (size_t)drow * 1024 + c) = w; }
    }
}
__device__ __forceinline__ void ph_final(const Params& p) {
    const int t = tid_opaque(), wid = __builtin_amdgcn_readfirstlane(t >> 6), lane = t & 63; const float* gam = p.in[I_FG];
    for (int r = blockIdx.x * 8 + wid; r < NTOK; r += gridDim.x * 8) {
        float* xp = p.out + (size_t)r * 1024; f32x4 xv[4]; float ss = 0.f;
#pragma unroll
        for (int i = 0; i < 4; ++i) { xv[i] = *(const f32x4*)(xp + i * 256 + lane * 4); ss += xv[i][0] * xv[i][0] + xv[i][1] * xv[i][1] + xv[i][2] * xv[i][2] + xv[i][3] * xv[i][3]; }
#pragma unroll
        for (int o = 32; o > 0; o >>= 1) ss += __shfl_xor(ss, o);
        const float rstd = rsqrtf(ss * (1.0f / 1024.0f) + EPS);
#pragma unroll
        for (int i = 0; i < 4; ++i) { const int c = i * 256 + lane * 4; *(f32x4*)(xp + c) = xv[i] * rstd * *(const f32x4*)(gam + c); }
    }
}

template <int L, int NB>
__device__ __forceinline__ void hy_load_conv(LAS u16* dst, const u16* src, float w0, float w1, float w2, float bb, int t) {
    constexpr int ZLD = L + 8, NIT = NB * L / 8 / NTHREADS;
    u32x4 rv[NIT]; float pl[NIT], pn[NIT];
#pragma unroll
    for (int i = 0; i < NIT; ++i) { const int v = t + i * NTHREADS; const int sq = v / (L / 8), p8 = (v % (L / 8)) * 8; const u16* pr = src + sq * L + p8;
        rv[i] = *(const u32x4*)pr; pl[i] = p8 > 0 ? bf2f(pr[-1]) : 0.f; pn[i] = p8 < L - 8 ? bf2f(pr[8]) : 0.f; }
#pragma unroll
    for (int i = 0; i < NIT; ++i) { const int v = t + i * NTHREADS; const int sq = v / (L / 8), p8 = (v % (L / 8)) * 8;
        float pv[8]; unpack8(rv[i], pv);
        float o[8];
#pragma unroll
        for (int k = 0; k < 8; ++k) { const float a = k > 0 ? pv[k - 1] : pl[i], d = k < 7 ? pv[k + 1] : pn[i]; o[k] = bb + w0 * a + w1 * pv[k] + w2 * d; }
        u32x4 w; w.x = pk2(o[0], o[1]); w.y = pk2(o[2], o[3]); w.z = pk2(o[4], o[5]); w.w = pk2(o[6], o[7]);
        *(LAS u32x4*)(dst + sq * ZLD + p8) = w; }
}
template <int L, int NB, int NTW, int MTW>
__device__ __forceinline__ void hyena_item(const Params& p, ldsp lds, int e, int c, int rowbase) {
    constexpr int NT1 = L / 64, ZLD = L + 8, RLD = 2 * L + 8;
    LAS u16* Zs = (LAS u16*)lds; LAS u16* Xs = Zs + NB * ZLD; LAS u16* R0 = Xs + NB * ZLD; LAS u16* R1 = R0 + RLD;
    const int t = tid_opaque(), wid = __builtin_amdgcn_readfirstlane(t >> 6), lane = t & 63, fr = lane & 15, fq = lane >> 4;
    const int nt0 = (NTW == 2) ? 2 * wid : (wid >> 1), mt0 = (MTW == 4) ? 0 : 2 * (wid & 1);
    const u16* projT = (const u16*)(p.ws + EV_PROJT); u16* yT = (u16*)(p.ws + EV_YT);
    const float* cw = p.in[I_EVCW] + (size_t)e * 3 * 2560; const float* cbias = p.in[I_EVCB] + e * 2560;
    const u16* kern = (const u16*)(p.ws + (L == 256 ? WS_KERNC : WS_KERNL));
    __syncthreads();
    if (t < NB) { unsigned zz; asm volatile("v_mov_b32 %0, 0" : "=v"(zz)); u32x4 zv; zv.x = zz; zv.y = zz; zv.z = zz; zv.w = zz; *(LAS u32x4*)(Zs + t * ZLD + L) = zv; }
    hy_load_conv<L, NB>(Zs, projT + (size_t)c * MG + rowbase, cw[c], cw[2560 + c], cw[5120 + c], cbias[c], t);
    const LAS unsigned* rl = (const LAS unsigned*)((fr & 1) ? R1 : R0) + ((L - fr + 8 * fq - (fr & 1)) >> 1);
#pragma unroll 1
    for (int o = 0; o < 2; ++o) {
        { const int gc = (o + 1) * 512 + c; hy_load_conv<L, NB>(Xs, projT + (size_t)gc * MG + rowbase, cw[gc], cw[2560 + gc], cw[5120 + gc], cbias[gc], t); }
        { const u32x4* img = (const u32x4*)(kern + (size_t)(o * 512 + c) * 2 * RLD);
          for (int v = t; v < 2 * RLD / 8; v += NTHREADS) ((LAS u32x4*)R0)[v] = img[v]; }
        __syncthreads();
        f32x4 acc[NTW][MTW];
#pragma unroll
        for (int i = 0; i < NTW; ++i)
#pragma unroll
            for (int m = 0; m < MTW; ++m) acc[i][m] = (f32x4){0.f, 0.f, 0.f, 0.f};
        if constexpr (MTW == 4) {
            const int t1lo = (16 * nt0) / NB, t1hi = (16 * (nt0 + NTW - 1) + 15) / NB;
            const int dlo = (t1lo - (NT1 - 1)) > -(NT1 - 1) ? (t1lo - (NT1 - 1)) : -(NT1 - 1), dhi = t1hi < NT1 - 1 ? t1hi : NT1 - 1;
            bf16x8 F[10];
#pragma unroll
            for (int q = 0; q < 6; ++q) { const LAS unsigned* rp = rl - 8 * (4 * dlo - 2 + q); u32x4 v; v.x = rp[0]; v.y = rp[1]; v.z = rp[2]; v.w = rp[3]; F[q] = __builtin_bit_cast(bf16x8, v); }
#pragma unroll 1
            for (int db = dlo; db <= dhi; db += 5) {
#pragma unroll
                for (int S = 0; S < 5; ++S) {
                    const int d1 = db + S;
                    if (d1 <= dhi) {
#pragma unroll
                        for (int q = 0; q < 4; ++q) { const LAS unsigned* rp = rl - 8 * (4 * (d1 + 1) + q); u32x4 v; v.x = rp[0]; v.y = rp[1]; v.z = rp[2]; v.w = rp[3]; F[(4 * S + 6 + q) % 10] = __builtin_bit_cast(bf16x8, v); }
#pragma unroll
                        for (int i = 0; i < NTW; ++i) {
                            const int lo = (16 * (nt0 + i)) / NB - d1, hi = (16 * (nt0 + i) + 15) / NB - d1;
                            if (hi >= 0 && lo <= NT1 - 1) {
                                const int n = 16 * (nt0 + i) + fr, t1 = n / NB, b = n % NB, s1 = t1 - d1; const bool ok = (unsigned)s1 < (unsigned)NT1;
                                const LAS u16* zp = Zs + b * ZLD + (ok ? 64 * s1 + 8 * fq : L);
                                const bf16x8 b0 = *(const LAS bf16x8*)zp, b1 = *(const LAS bf16x8*)(zp + (ok ? 32 : 0));
#pragma unroll
                                for (int m = 0; m < MTW; ++m) { acc[i][m] = MFMA(F[(4 * S + m + 2) % 10], b0, acc[i][m]); acc[i][m] = MFMA(F[(4 * S + m) % 10], b1, acc[i][m]); }
                            }
                        }
                    }
                }
            }
        } else {
#pragma unroll 1
        for (int d1 = -(NT1 - 1); d1 <= NT1 - 1; ++d1) {
            bool valid[NTW]; bool any = false;
#pragma unroll
            for (int i = 0; i < NTW; ++i) { const int lo = (16 * (nt0 + i)) / NB - d1, hi = (16 * (nt0 + i) + 15) / NB - d1; valid[i] = hi >= 0 && lo <= NT1 - 1; any = any || valid[i]; }
            if (!any) continue;
            bf16x8 af[MTW + 2];
#pragma unroll
            for (int q = 0; q < MTW + 2; ++q) { const int delta = mt0 - 2 + q; const LAS unsigned* rp = rl - (32 * d1 + 8 * delta);
                u32x4 v; v.x = rp[0]; v.y = rp[1]; v.z = rp[2]; v.w = rp[3]; af[q] = __builtin_bit_cast(bf16x8, v); }
#pragma unroll
            for (int i = 0; i < NTW; ++i) {
                if (!valid[i]) continue;
                const int n = 16 * (nt0 + i) + fr, t1 = n / NB, b = n % NB, s1 = t1 - d1; const bool ok = (unsigned)s1 < (unsigned)NT1;
                const LAS u16* zp = Zs + b * ZLD + 64 * (ok ? s1 : 0) + 8 * fq;
#pragma unroll
                for (int kt = 0; kt < 2; ++kt) {
                    bf16x8 bf = *(const LAS bf16x8*)(zp + 32 * kt);
                    if (!ok) bf = (bf16x8){0, 0, 0, 0, 0, 0, 0, 0};
#pragma unroll
                    for (int m = 0; m < MTW; ++m) acc[i][m] = MFMA(af[m + 2 - 2 * kt], bf, acc[i][m]);
                }
            }
        }
        }
        __syncthreads();
        { const float hb = p.in[I_HBIAS][(e * 2 + o) * 512 + c];
#pragma unroll
          for (int i = 0; i < NTW; ++i) { const int n = 16 * (nt0 + i) + fr, t1 = n / NB, b = n % NB;
#pragma unroll
              for (int m = 0; m < MTW; ++m) { const int tt = 64 * t1 + 16 * (mt0 + m) + 4 * fq;
                  const u32x2 zo = *(const LAS u32x2*)(Zs + b * ZLD + tt), xo = *(const LAS u32x2*)(Xs + b * ZLD + tt);
                  const float z0 = __uint_as_float(zo.x << 16), z1 = __uint_as_float(zo.x & 0xffff0000u), z2 = __uint_as_float(zo.y << 16), z3 = __uint_as_float(zo.y & 0xffff0000u);
                  const float x0 = __uint_as_float(xo.x << 16), x1 = __uint_as_float(xo.x & 0xffff0000u), x2 = __uint_as_float(xo.y << 16), x3 = __uint_as_float(xo.y & 0xffff0000u);
                  const float r0 = x0 * (acc[i][m][0] + z0 * hb), r1 = x1 * (acc[i][m][1] + z1 * hb), r2 = x2 * (acc[i][m][2] + z2 * hb), r3 = x3 * (acc[i][m][3] + z3 * hb);
                  if (o == 0) { u32x2 w; w.x = pk2(r0, r1); w.y = pk2(r2, r3); *(LAS u32x2*)(Zs + b * ZLD + tt) = w; }
                  else { u32x2 w; w.x = pk2(r0, r1); w.y = pk2(r2, r3); *(u32x2*)(yT + (size_t)c * MG + rowbase + b * L + tt) = w; } } } }
        __syncthreads();
    }
}
__device__ __forceinline__ void ph_hytrans(const Params& p, ldsp lds, int g) {
    LAS u16* tile = (LAS u16*)lds;
    const int t = tid_opaque();
    const u16* yT = (const u16*)(p.ws + EV_YT); u16* yg = (u16*)(p.ws + EV_Y) + (size_t)g * MG * 1024;
    for (int it = blockIdx.x; it < 2560; it += gridDim.x) {
        const int r0 = (it >> 3) * 64, c0 = (it & 7) * 64;
        __syncthreads();
        { const int c = t >> 3, r8 = (t & 7) * 8; *(LAS u32x4*)(tile + c * 72 + r8) = *(const u32x4*)(yT + (size_t)(c0 + c) * MG + r0 + r8); }
        __syncthreads();
        { const int r = t >> 3, c8 = (t & 7) * 8; u32x4 w;
          w.x = (unsigned)tile[(c8 + 0) * 72 + r] | ((unsigned)tile[(c8 + 1) * 72 + r] << 16); w.y = (unsigned)tile[(c8 + 2) * 72 + r] | ((unsigned)tile[(c8 + 3) * 72 + r] << 16);
          w.z = (unsigned)tile[(c8 + 4) * 72 + r] | ((unsigned)tile[(c8 + 5) * 72 + r] << 16); w.w = (unsigned)tile[(c8 + 6) * 72 + r] | ((unsigned)tile[(c8 + 7) * 72 + r] << 16);
          *(u32x4*)(yg + (size_t)(r0 + r) * 1024 + c0 + c8) = w; }
    }
}
__device__ __forceinline__ void ph_hyena(const Params& p, ldsp lds, int e) {
    for (int it = blockIdx.x; it < 1024; it += gridDim.x) {
        if (it < 512) hyena_item<4096, 4, 2, 4>(p, lds, e, it, CTXG); else hyena_item<256, 16, 1, 2>(p, lds, e, it - 512, 0);
    }
}

typedef short s16x4 __attribute__((ext_vector_type(4)));
__device__ __forceinline__ bf16x8 ld_tr(const LAS u16* base, int ld, int rowA, int rowB, int col0, int lane) {
    const int q = (lane & 15) >> 2, pp = lane & 3;
    const s16x4 v0 = __builtin_amdgcn_ds_read_tr16_b64_v4i16((LAS s16x4*)(base + (rowA + q) * ld + col0 + 4 * pp));
    const s16x4 v1 = __builtin_amdgcn_ds_read_tr16_b64_v4i16((LAS s16x4*)(base + (rowB + q) * ld + col0 + 4 * pp));
    return (bf16x8){v0[0], v0[1], v0[2], v0[3], v1[0], v1[1], v1[2], v1[3]};
}
__device__ __forceinline__ float wave_cumsum(float v, int lane) {
#pragma unroll
    for (int o = 1; o < 64; o <<= 1) { const float u = __shfl_up(v, o); if (lane >= o) v += u; } return v; }
__device__ __forceinline__ float wave_cummax(float v, int lane) {
#pragma unroll
    for (int o = 1; o < 64; o <<= 1) { const float u = __shfl_up(v, o); if (lane >= o) v = fmaxf(v, u); } return v; }
__device__ __forceinline__ float wave_max(float v) {
#pragma unroll
    for (int o = 32; o > 0; o >>= 1) v = fmaxf(v, __shfl_xor(v, o)); return v; }

__device__ __forceinline__ void ph_mlact(const Params& p, int e) {
    const u16* projR = (const u16*)(p.ws + EV_PROJR); u16* qk = (u16*)(p.ws + EV_H);
    const float* cw = p.in[I_EVCW] + (size_t)e * 3 * 2560 + 1536; const float* cbias = p.in[I_EVCB] + e * 2560 + 1536;
    const int t = tid_opaque(), c8 = (t & 127) * 8, rg = t >> 7;
    float w0[8], w1[8], w2[8], bb[8]; ld8f(cw + c8, w0); ld8f(cw + 2560 + c8, w1); ld8f(cw + 5120 + c8, w2); ld8f(cbias + c8, bb);
    const float scl = c8 >= 512 ? 0.08838834764831845f : 1.0f;
    for (int r0 = (blockIdx.x * 4 + rg) * 8; r0 < MG; r0 += gridDim.x * 32) {
        const int pos0 = r0 < CTXG ? (r0 & 255) : ((r0 - CTXG) & 4095), L = r0 < CTXG ? 256 : 4096;
        u32x4 rr[10];
#pragma unroll
        for (int i = 0; i < 10; ++i) { const bool ok = (i > 0 || pos0 > 0) && (i < 9 || pos0 + 8 < L); rr[i] = ok ? *(const u32x4*)(projR + (size_t)(r0 - 1 + i) * EVR + c8) : (u32x4){0u, 0u, 0u, 0u}; }
#pragma unroll
        for (int i = 0; i < 8; ++i) { float pm[8], p0[8], pp[8]; unpack8(rr[i], pm); unpack8(rr[i + 1], p0); unpack8(rr[i + 2], pp);
            float o8[8];
#pragma unroll
            for (int j = 0; j < 8; ++j) o8[j] = siluf(bb[j] + w0[j] * pm[j] + w1[j] * p0[j] + w2[j] * pp[j]) * scl;
            u32x4 w; w.x = pk2(o8[0], o8[1]); w.y = pk2(o8[2], o8[3]); w.z = pk2(o8[4], o8[5]); w.w = pk2(o8[6], o8[7]);
            *(u32x4*)(qk + (size_t)(r0 + i) * 1024 + c8) = w; }
    }
}
__device__ __forceinline__ void ph_mlA(const Params& p, ldsp lds, int e) {
    LAS u16* Ks = (LAS u16*)lds; LAS u16* Vs = Ks + 64 * 144; LAS float* wS = (LAS float*)(Vs + 64 * 144);
    const int t = tid_opaque(), wid = __builtin_amdgcn_readfirstlane(t >> 6), lane = t & 63, fr = lane & 15, fq = lane >> 4;
    const u16* projR = (const u16*)(p.ws + EV_PROJR); const u16* qk = (const u16*)(p.ws + EV_H);
    u16* CT = (u16*)(p.ws + EV_ST); float* nst = (float*)(p.ws + WS_NST); float* sc = (float*)(p.ws + WS_SC);
    const float* gb = p.in[I_MGB] + e * 16;
    auto issue = [&](int it, u32x4 (&rk)[2], u32x4 (&rv)[2], u16& gri, u16& grf) {
        int chi, j, L, seqrow0;
        if (it < 512) { chi = it >> 2; j = it & 3; L = 256; seqrow0 = (chi >> 3) * 256; }
        else { const int i2 = it - 512; chi = i2 >> 6; j = i2 & 63; L = 4096; seqrow0 = CTXG + (chi >> 3) * 4096; }
        const int head = (chi >> 1) & 3, dir = chi & 1;
#pragma unroll
        for (int q = 0; q < 2; ++q) { const int v = t + q * 512, l = v >> 4, dg = (v & 15) * 8; const int pos = dir ? L - 1 - (64 * j + l) : 64 * j + l;
            rk[q] = *(const u32x4*)(qk + (size_t)(seqrow0 + pos) * 1024 + 512 + head * 128 + dg); rv[q] = *(const u32x4*)(projR + (size_t)(seqrow0 + pos) * EVR + 1024 + head * 128 + dg); }
        { const int pos = dir ? L - 1 - (64 * j + lane) : 64 * j + lane; const u16* pr = projR + (size_t)(seqrow0 + pos) * EVR + (3584 - 1536); gri = pr[(dir * 2 + 0) * 4 + head]; grf = pr[(dir * 2 + 1) * 4 + head]; }
    };
    u32x4 nrk[2], nrv[2]; u16 ngri = 0, ngrf = 0;
    if ((int)blockIdx.x < 2560) issue((int)blockIdx.x, nrk, nrv, ngri, ngrf);
    for (int it = blockIdx.x; it < 2560; it += gridDim.x) {
        int chi, j, L, seqrow0, sig;
        if (it < 512) { chi = it >> 2; j = it & 3; L = 256; sig = chi >> 3; seqrow0 = sig * 256; }
        else { const int i2 = it - 512; chi = i2 >> 6; j = i2 & 63; L = 4096; sig = chi >> 3; seqrow0 = CTXG + sig * 4096; }
        const int head = (chi >> 1) & 3, dir = chi & 1;
        u32x4 rk[2], rv[2]; rk[0] = nrk[0]; rk[1] = nrk[1]; rv[0] = nrv[0]; rv[1] = nrv[1];
        const u16 gri = ngri, grf = ngrf;
        if (it + (int)gridDim.x < 2560) issue(it + (int)gridDim.x, nrk, nrv, ngri, ngrf);
        __syncthreads();
        if (wid == 0) {
            const float gi = bf2f(gri) + gb[(dir * 2 + 0) * 4 + head];
            const float lf = logsigf(bf2f(grf) + gb[(dir * 2 + 1) * 4 + head]);
            const float b = wave_cumsum(lf, lane); const float b63 = __shfl(b, 63); const float uu = gi - b; const float gmax = wave_max(uu);
            wS[lane] = __expf(uu - gmax);
            if (lane == 0) { sc[it * 4 + 0] = b63; sc[it * 4 + 1] = b63 + gmax; }
        }
        __syncthreads();
#pragma unroll
        for (int q = 0; q < 2; ++q) { const int v = t + q * 512, l = v >> 4, dg = (v & 15) * 8;
            float kv[8]; unpack8(rk[q], kv); const float wl = wS[l];
            u32x4 w; w.x = pk2(kv[0] * wl, kv[1] * wl); w.y = pk2(kv[2] * wl, kv[3] * wl); w.z = pk2(kv[4] * wl, kv[5] * wl); w.w = pk2(kv[6] * wl, kv[7] * wl);
            *(LAS u32x4*)(Ks + l * 144 + dg) = w; *(LAS u32x4*)(Vs + l * 144 + dg) = rv[q]; }
        __syncthreads();
        {
            f32x4 acc[8];
#pragma unroll
            for (int n = 0; n < 8; ++n) acc[n] = (f32x4){0.f, 0.f, 0.f, 0.f};
#pragma unroll
            for (int kt = 0; kt < 2; ++kt) { const bf16x8 a = ld_tr(Ks, 144, 32 * kt + 8 * fq, 32 * kt + 8 * fq + 4, 16 * wid, lane);
#pragma unroll
                for (int n = 0; n < 8; ++n) acc[n] = MFMA(a, ld_tr(Vs, 144, 32 * kt + 8 * fq, 32 * kt + 8 * fq + 4, 16 * n, lane), acc[n]); }
            u16* cp = CT + (size_t)it * 16384;
#pragma unroll
            for (int n = 0; n < 8; ++n) { u32x2 w; w.x = pk2(acc[n][0], acc[n][1]); w.y = pk2(acc[n][2], acc[n][3]); *(u32x2*)(cp + (16 * n + fr) * 128 + 16 * wid + 4 * fq) = w; }
        }
        if (t < 128) { float sm = 0.f; for (int l = 0; l < 64; ++l) sm += bf2f(Ks[l * 144 + t]); nst[it * 128 + t] = sm; }
    }
}
template <int NC, bool ISCTX>
__device__ __forceinline__ void mlB_part(const Params& p, int e, int g) {
    unsigned* CT = (unsigned*)(p.ws + EV_ST); float* nst = (float*)(p.ws + WS_NST); const float* sc = (const float*)(p.ws + WS_SC); float* msc = (float*)(p.ws + WS_MSC);
    const int nch = ISCTX ? 128 : 32, total = nch * 8320;
    for (int idx = blockIdx.x * NTHREADS + tid_opaque(); idx < total; idx += gridDim.x * NTHREADS) {
        const int chi = idx / 8320, el = idx % 8320; const int sig = chi >> 3, head = (chi >> 1) & 3, dir = chi & 1;
        const int itembase = ISCTX ? chi * 4 : 512 + chi * 64;
        const bool isn = el >= 8192; const int ee = el >> 6, d = (el & 63) * 2;
        float C0 = 0.f, C1 = 0.f, m = 0.f, mrec = 0.f;
        if (!ISCTX) { const int b = g * 4 + sig; const size_t sb = (size_t)((b * 2 + e) * 2 + dir) * 4 + head;
            m = p.in[I_SM][sb];
            if (isn) C0 = p.in[I_SN][sb * 128 + (el - 8192)]; else { C0 = p.in[I_SC][(sb * 128 + d) * 128 + ee]; C1 = p.in[I_SC][(sb * 128 + d + 1) * 128 + ee]; } }
        constexpr int JB = NC < 16 ? NC : 16;
#pragma unroll 1
        for (int j0 = 0; j0 < NC; j0 += JB) {
            unsigned Lu[JB]; float Lf[JB];
#pragma unroll
            for (int j = 0; j < JB; ++j) { if (isn) Lf[j] = nst[(itembase + j0 + j) * 128 + (el - 8192)]; else Lu[j] = CT[(size_t)(itembase + j0 + j) * 8192 + el]; }
#pragma unroll
            for (int j = 0; j < JB; ++j) {
                const float a = sc[(itembase + j0 + j) * 4 + 0], gl = sc[(itembase + j0 + j) * 4 + 1];
                if (el == j0 + j) mrec = m;
                const float mn = fmaxf(a + m, gl); const float fa = __expf(a + m - mn), fb = __expf(gl - mn);
                if (isn) { const float t0 = Lf[j]; Lf[j] = C0; C0 = fa * C0 + fb * t0; }
                else { const float t0 = __uint_as_float(Lu[j] << 16), t1 = __uint_as_float(Lu[j] & 0xffff0000u); Lu[j] = pk2(C0, C1); C0 = fa * C0 + fb * t0; C1 = fa * C1 + fb * t1; }
                m = mn;
            }
#pragma unroll
            for (int j = 0; j < JB; ++j) { if (isn) nst[(itembase + j0 + j) * 128 + (el - 8192)] = Lf[j]; else CT[(size_t)(itembase + j0 + j) * 8192 + el] = Lu[j]; }
        }
        if (el < NC) msc[itembase + el] = mrec;
        if (ISCTX) { const int b = g * 16 + sig; const size_t sb = (size_t)((b * 2 + e) * 2 + dir) * 4 + head;
            if (isn) p.out[OUT_N + sb * 128 + (el - 8192)] = C0; else { p.out[OUT_C + (sb * 128 + d) * 128 + ee] = C0; p.out[OUT_C + (sb * 128 + d + 1) * 128 + ee] = C1; }
            if (el == 0) p.out[OUT_M + sb] = m; }
    }
}
__device__ __forceinline__ void ph_mlB(const Params& p, int e, int g) { mlB_part<64, false>(p, e, g); mlB_part<4, true>(p, e, g); }
__device__ __forceinline__ void ph_mlC(const Params& p, ldsp lds, int e, int g) {
    LAS u16* qs = (LAS u16*)lds; LAS u16* ks = qs + 64 * 136; LAS u16* Vs = ks + 64 * 136; LAS u16* CTs = Vs + 64 * 144; LAS u16* Sb = CTs + 144 * 136;
    LAS float* hbuf = (LAS float*)(Sb + 64 * 72); LAS float* rt = hbuf + 64 * 128; LAS float* uu = rt + 64; LAS float* ain = uu + 64; LAS float* emt = ain + 64; LAS float* den = emt + 64;
    const int t = tid_opaque(), wid = __builtin_amdgcn_readfirstlane(t >> 6), lane = t & 63, fr = lane & 15, fq = lane >> 4;
    const u16* projR = (const u16*)(p.ws + EV_PROJR); const u16* qk = (const u16*)(p.ws + EV_H);
    const u16* CT = (const u16*)(p.ws + EV_ST); const float* nst = (const float*)(p.ws + WS_NST); const float* msc = (const float*)(p.ws + WS_MSC);
    u16* yg = (u16*)(p.ws + EV_Y) + (size_t)g * MG * 1024;
    const float* gb = p.in[I_MGB] + e * 16;
    for (int it = blockIdx.x; it < 1280; it += gridDim.x) {
        int sig, head, jo, L, NC, seqrow0, cbase; bool isctx = it >= 1024;
        if (isctx) { const int i2 = it - 1024; sig = i2 >> 4; head = (i2 >> 2) & 3; jo = i2 & 3; L = 256; NC = 4; seqrow0 = sig * 256; }
        else { sig = it >> 8; head = (it >> 6) & 3; jo = it & 63; L = 4096; NC = 64; seqrow0 = CTXG + sig * 4096; }
        cbase = (sig * 4 + head) * 2;
#pragma unroll 1
        for (int dir = 0; dir < 2; ++dir) {
            const int jd = dir ? NC - 1 - jo : jo; const int chi = cbase + dir; const int item = (isctx ? chi * 4 : 512 + chi * 64) + jd;
            const float mst = msc[item];
            u32x4 rq[2], rk[2], rv[2], rc[4];
#pragma unroll
            for (int q = 0; q < 2; ++q) { const int v = t + q * 512, l = v >> 4, dg = (v & 15) * 8; const int pos = dir ? L - 1 - (64 * jd + l) : 64 * jd + l;
                const u16* qp = qk + (size_t)(seqrow0 + pos) * 1024 + head * 128 + dg; rq[q] = *(const u32x4*)qp; rk[q] = *(const u32x4*)(qp + 512);
                rv[q] = *(const u32x4*)(projR + (size_t)(seqrow0 + pos) * EVR + 1024 + head * 128 + dg); }
#pragma unroll
            for (int q = 0; q < 4; ++q) { const int v = t + q * 512; rc[q] = *(const u32x4*)(CT + (size_t)item * 16384 + v * 8); }
            u16 gri, grf;
            { const int pos = dir ? L - 1 - (64 * jd + lane) : 64 * jd + lane; const u16* pr = projR + (size_t)(seqrow0 + pos) * EVR + (3584 - 1536); gri = pr[(dir * 2 + 0) * 4 + head]; grf = pr[(dir * 2 + 1) * 4 + head]; }
            const float nval = nst[item * 128 + (t & 127)];
            __syncthreads();
            if (wid == 0) {
                const float gi = bf2f(gri) + gb[(dir * 2 + 0) * 4 + head];
                const float lf = logsigf(bf2f(grf) + gb[(dir * 2 + 1) * 4 + head]);
                const float b = wave_cumsum(lf, lane); const float u_ = gi - b; const float pm = wave_cummax(u_, lane); const float mt = b + fmaxf(mst, pm);
                rt[lane] = b - mt; uu[lane] = u_; ain[lane] = __expf(b + mst - mt); emt[lane] = __expf(-mt);
            }
#pragma unroll
            for (int q = 0; q < 2; ++q) { const int v = t + q * 512, l = v >> 4, dg = (v & 15) * 8;
                *(LAS u32x4*)(qs + l * 136 + dg) = rq[q]; *(LAS u32x4*)(ks + l * 136 + dg) = rk[q]; *(LAS u32x4*)(Vs + l * 144 + dg) = rv[q]; }
            if (t < 128) { const int l = t >> 1, hf = t & 1; u32x4 w; w.x = hf ? 0u : 0x3F80u; w.y = 0u; w.z = 0u; w.w = 0u; *(LAS u32x4*)(Vs + l * 144 + 128 + hf * 8) = w; }
#pragma unroll
            for (int q = 0; q < 4; ++q) { const int v = t + q * 512, ee = v >> 4, dg = (v & 15) * 8; *(LAS u32x4*)(CTs + ee * 136 + dg) = rc[q]; }
            for (int idx = t; idx < 16 * 128; idx += NTHREADS) { const int r = idx >> 7, d = idx & 127; CTs[(128 + r) * 136 + d] = r == 0 ? f2bf(nval) : (u16)0; }
            __syncthreads();
            {
                const int mt_ = wid >> 1;
                f32x4 a2[2] = {(f32x4){0.f, 0.f, 0.f, 0.f}, (f32x4){0.f, 0.f, 0.f, 0.f}};
#pragma unroll
                for (int kt = 0; kt < 4; ++kt) { const bf16x8 a = ldfrag(qs, (16 * mt_ + fr) * 136 + kt * 32 + fq * 8);
#pragma unroll
                    for (int i = 0; i < 2; ++i) { const int nt = (wid & 1) * 2 + i; const bf16x8 b = ldfrag(ks, (16 * nt + fr) * 136 + kt * 32 + fq * 8); a2[i] = MFMA(a, b, a2[i]); } }
#pragma unroll
                for (int i = 0; i < 2; ++i) { const int s_ = 16 * ((wid & 1) * 2 + i) + fr; const float us = uu[s_];
#pragma unroll
                    for (int jj = 0; jj < 4; ++jj) { const int l = 16 * mt_ + 4 * fq + jj; const float w = s_ <= l ? __expf(rt[l] + us) : 0.f; Sb[l * 72 + s_] = f2bf(a2[i][jj] * w); } }
            }
            __syncthreads();
            f32x4 a1[4], a2[4], d1 = (f32x4){0.f, 0.f, 0.f, 0.f}, d2 = d1;
            { const bf16x8 v0 = ld_tr(Vs, 144, 8 * fq, 8 * fq + 4, 16 * wid, lane), v1 = ld_tr(Vs, 144, 32 + 8 * fq, 32 + 8 * fq + 4, 16 * wid, lane);
#pragma unroll
              for (int mt_ = 0; mt_ < 4; ++mt_) { a1[mt_] = (f32x4){0.f, 0.f, 0.f, 0.f}; a2[mt_] = a1[mt_];
                a1[mt_] = MFMA(ldfrag(Sb, (16 * mt_ + fr) * 72 + fq * 8), v0, a1[mt_]); a1[mt_] = MFMA(ldfrag(Sb, (16 * mt_ + fr) * 72 + 32 + fq * 8), v1, a1[mt_]);
#pragma unroll
                for (int kt = 0; kt < 4; ++kt) a2[mt_] = MFMA(ldfrag(qs, (16 * mt_ + fr) * 136 + kt * 32 + fq * 8), ldfrag(CTs, (16 * wid + fr) * 136 + kt * 32 + fq * 8), a2[mt_]); } }
            {
                const int mtw = wid & 3;
                const bf16x8 v0 = ld_tr(Vs, 144, 8 * fq, 8 * fq + 4, 128, lane), v1 = ld_tr(Vs, 144, 32 + 8 * fq, 32 + 8 * fq + 4, 128, lane);
                d1 = MFMA(ldfrag(Sb, (16 * mtw + fr) * 72 + fq * 8), v0, d1); d1 = MFMA(ldfrag(Sb, (16 * mtw + fr) * 72 + 32 + fq * 8), v1, d1);
#pragma unroll
                for (int kt = 0; kt < 4; ++kt) d2 = MFMA(ldfrag(qs, (16 * mtw + fr) * 136 + kt * 32 + fq * 8), ldfrag(CTs, (128 + fr) * 136 + kt * 32 + fq * 8), d2);
                if (wid < 4 && fr == 0) {
#pragma unroll
                    for (int jj = 0; jj < 4; ++jj) { const int l = 16 * mtw + 4 * fq + jj; den[l] = d1[jj] + ain[l] * d2[jj]; } }
            }
            __syncthreads();
#pragma unroll
            for (int mt_ = 0; mt_ < 4; ++mt_)
#pragma unroll
                for (int jj = 0; jj < 4; ++jj) { const int l = 16 * mt_ + 4 * fq + jj, ee = 16 * wid + fr;
                    const float h = (a1[mt_][jj] + ain[l] * a2[mt_][jj]) * __builtin_amdgcn_rcpf(fmaxf(fabsf(den[l]), emt[l]));
                    if (dir == 0) hbuf[l * 128 + ee] = h; else hbuf[(63 - l) * 128 + ee] += h; }
        }
        __syncthreads();
        { const int row = t >> 3, seg = t & 7; const int grow = seqrow0 + 64 * jo + row;
          float v[16], ss = 0.f;
#pragma unroll
          for (int i = 0; i < 16; ++i) { v[i] = hbuf[row * 128 + seg * 16 + i]; ss += v[i] * v[i]; }
          ss += __shfl_xor(ss, 1); ss += __shfl_xor(ss, 2); ss += __shfl_xor(ss, 4);
          const float rstd = rsqrtf(ss * (1.0f / 128.0f) + EPS);
          const u16* op = projR + (size_t)grow * EVR + (3072 - 1536) + head * 128 + seg * 16; const float* ng = p.in[I_MNG] + e * 512 + head * 128 + seg * 16;
          float o0[8], o1[8]; ld8(op, o0); ld8(op + 8, o1);
          u32x4 w0, w1;
          w0.x = pk2(v[0] * rstd * ng[0] * sigmf(o0[0]), v[1] * rstd * ng[1] * sigmf(o0[1])); w0.y = pk2(v[2] * rstd * ng[2] * sigmf(o0[2]), v[3] * rstd * ng[3] * sigmf(o0[3]));
          w0.z = pk2(v[4] * rstd * ng[4] * sigmf(o0[4]), v[5] * rstd * ng[5] * sigmf(o0[5])); w0.w = pk2(v[6] * rstd * ng[6] * sigmf(o0[6]), v[7] * rstd * ng[7] * sigmf(o0[7]));
          w1.x = pk2(v[8] * rstd * ng[8] * sigmf(o1[0]), v[9] * rstd * ng[9] * sigmf(o1[1])); w1.y = pk2(v[10] * rstd * ng[10] * sigmf(o1[2]), v[11] * rstd * ng[11] * sigmf(o1[3]));
          w1.z = pk2(v[12] * rstd * ng[12] * sigmf(o1[4]), v[13] * rstd * ng[13] * sigmf(o1[5])); w1.w = pk2(v[14] * rstd * ng[14] * sigmf(o1[6]), v[15] * rstd * ng[15] * sigmf(o1[7]));
          u16* yp = yg + (size_t)grow * 1024 + 512 + head * 128 + seg * 16; *(u32x4*)yp = w0; *(u32x4*)(yp + 8) = w1; }
    }
}

__device__ __forceinline__ bf16x8 ld_perm(const LAS u16* rowp, int kt, int fq) {
    const u32x2 a = *(const LAS u32x2*)(rowp + 32 * kt + 4 * fq), b = *(const LAS u32x2*)(rowp + 32 * kt + 16 + 4 * fq);
    u32x4 v; v.x = a.x; v.y = a.y; v.z = b.x; v.w = b.y; return __builtin_bit_cast(bf16x8, v); }
__device__ __forceinline__ bf16x8 pack_acc(f32x4 a, f32x4 b) { u32x4 v; v.x = pk2(a[0], a[1]); v.y = pk2(a[2], a[3]); v.z = pk2(b[0], b[1]); v.w = pk2(b[2], b[3]); return __builtin_bit_cast(bf16x8, v); }
__device__ __forceinline__ void ph_ssdact(const Params& p, int o) {
    const u16* raw = (const u16*)(p.ws + OD_RAW); u16* act = (u16*)(p.ws + OD_ACT);
    const float* cw = p.in[I_ODCW] + (size_t)o * 3 * 4096; const float* cbias = p.in[I_ODCB] + o * 4096;
    const int t = tid_opaque(), c8 = (t & 511) * 8;
    float w0[8], w1[8], w2[8], bb[8]; ld8f(cw + c8, w0); ld8f(cw + 4096 + c8, w1); ld8f(cw + 8192 + c8, w2); ld8f(cbias + c8, bb);
    for (int r0 = blockIdx.x * 8; r0 < MG; r0 += gridDim.x * 8) {
        const int pos0 = r0 < CTXG ? (r0 & 255) : ((r0 - CTXG) & 4095), L = r0 < CTXG ? 256 : 4096;
        u32x4 rr[10];
#pragma unroll
        for (int i = 0; i < 10; ++i) { const bool ok = (i > 0 || pos0 > 0) && (i < 9 || pos0 + 8 < L); rr[i] = ok ? *(const u32x4*)(raw + (size_t)(r0 - 1 + i) * 4096 + c8) : (u32x4){0u, 0u, 0u, 0u}; }
#pragma unroll
        for (int i = 0; i < 8; ++i) { float pm[8], p0[8], pp[8]; unpack8(rr[i], pm); unpack8(rr[i + 1], p0); unpack8(rr[i + 2], pp);
            float o8[8];
#pragma unroll
            for (int j = 0; j < 8; ++j) o8[j] = siluf(bb[j] + w0[j] * pm[j] + w1[j] * p0[j] + w2[j] * pp[j]);
            u32x4 w; w.x = pk2(o8[0], o8[1]); w.y = pk2(o8[2], o8[3]); w.z = pk2(o8[4], o8[5]); w.w = pk2(o8[6], o8[7]);
            *(u32x4*)(act + (size_t)(r0 + i) * 4096 + c8) = w; }
    }
}
template <bool PASSB>
__device__ __forceinline__ void ssd_pass(const Params& p, ldsp lds, int o, int g) {
    LAS u16* Cm = (LAS u16*)lds; LAS u16* Bm = Cm + 64 * 144; LAS u16* X = Bm + 64 * 144; LAS u16* X2 = X + 64 * 272;
    LAS float* cbL = (LAS float*)(X2 + 64 * 272); LAS float* acsb = cbL + 64 * 68; LAS float* dtsb = acsb + 512;
    const int t = tid_opaque(), wid = __builtin_amdgcn_readfirstlane(t >> 6), lane = t & 63, fr = lane & 15, fq = lane >> 4;
    const int hh = wid >> 1, pt0 = 2 * (wid & 1);
    const u16* act = (const u16*)(p.ws + OD_ACT); const u16* zd = (const u16*)(p.ws + OD_ZD);
    float* segbuf = (float*)(p.ws + OD_SEG); float* dseg = (float*)(p.ws + OD_DSEG);
    const int nitems = PASSB ? 768 : 448;
    for (int it = blockIdx.x; it < nitems; it += gridDim.x) {
        int sig, grp, dir, seg, L, nsteps, seqrow0; bool islat = true;
        if (PASSB) {
            islat = it < 512;
            if (islat) { seg = it & 7; dir = (it >> 3) & 1; grp = (it >> 4) & 7; sig = it >> 7; L = 4096; nsteps = 8; seqrow0 = CTXG + sig * 4096; }
            else { const int i2 = it - 512; seg = 0; dir = i2 & 1; grp = (i2 >> 1) & 7; sig = i2 >> 4; L = 256; nsteps = 4; seqrow0 = sig * 256; }
        } else { seg = it % 7; const int r = it / 7; dir = r & 1; grp = (r >> 1) & 7; sig = r >> 4; L = 4096; nsteps = 8; seqrow0 = CTXG + sig * 4096; }
        const int head = grp * 4 + hh, chain = (sig * 8 + grp) * 2 + dir, jd0 = seg * 8;
        u16* ydir = (u16*)(p.ws + (dir ? OD_YB : OD_YF));
        f32x4 ST[2][8];
        {
            const float* sp = nullptr;
            if (PASSB && islat) sp = seg == 0 ? p.in[I_SSD] + ((size_t)(((g * 4 + sig) * 2 + o) * 2 + dir) * 32 + head) * 8192 : segbuf + ((size_t)(chain * 7 + seg - 1) * 4 + hh) * 8192;
#pragma unroll
            for (int pi = 0; pi < 2; ++pi)
#pragma unroll
                for (int n = 0; n < 8; ++n) ST[pi][n] = sp ? *(const f32x4*)(sp + (16 * (pt0 + pi) + fr) * 128 + 16 * n + 4 * fq) : (f32x4){0.f, 0.f, 0.f, 0.f};
        }
        float Aneg = 0.f, dtb = 0.f, dsum = 0.f;
        if (wid < 4) { const int hd = grp * 4 + wid; Aneg = -__expf(p.in[I_ALOG][(o * 2 + dir) * 32 + hd]); dtb = p.in[I_DTB][(o * 2 + dir) * 32 + hd]; }
        __syncthreads();
        float dtp_n = 0.f;
        if (wid < 4) { const int pos = dir ? L - 1 - (64 * jd0 + lane) : 64 * jd0 + lane;
            const float dt = softplusf(bf2f(zd[(size_t)(seqrow0 + pos) * ZDL + 2048 + dir * 32 + grp * 4 + wid]) + dtb); const float ac = wave_cumsum(dt * Aneg, lane);
            dtsb[wid * 64 + lane] = dt; acsb[wid * 64 + lane] = ac; dsum += __shfl(ac, 63);
            const int pos1 = dir ? L - 1 - (64 * (jd0 + 1) + lane) : 64 * (jd0 + 1) + lane; dtp_n = bf2f(zd[(size_t)(seqrow0 + pos1) * ZDL + 2048 + dir * 32 + grp * 4 + wid]); }
        __syncthreads();
        u32x4 rb[2], rx[4];
#pragma unroll
        for (int q = 0; q < 2; ++q) { const int v = t + q * 512, l = v >> 4, ng = (v & 15) * 8; const int pos = dir ? L - 1 - (64 * jd0 + l) : 64 * jd0 + l;
            const u16* rowp = act + (size_t)(seqrow0 + pos) * 4096; rb[q] = *(const u32x4*)(rowp + 2048 + grp * 128 + ng); }
#pragma unroll
        for (int q = 0; q < 4; ++q) { const int v = t + q * 512, l = v >> 5, cg_ = (v & 31) * 8; const int pos = dir ? L - 1 - (64 * jd0 + l) : 64 * jd0 + l;
            rx[q] = *(const u32x4*)(act + (size_t)(seqrow0 + pos) * 4096 + grp * 256 + cg_); }
#pragma unroll 1
        for (int st = 0; st < nsteps; ++st) {
            const int jd = jd0 + st, cur = st & 1;
            {
                u32x4 rc[2];
                if (PASSB) {
#pragma unroll
                    for (int q = 0; q < 2; ++q) { const int v = t + q * 512, l = v >> 4, ng = (v & 15) * 8; const int pos = dir ? L - 1 - (64 * jd + l) : 64 * jd + l;
                        rc[q] = *(const u32x4*)(act + (size_t)(seqrow0 + pos) * 4096 + 3072 + grp * 128 + ng); } }
#pragma unroll
                for (int q = 0; q < 2; ++q) { const int v = t + q * 512, l = v >> 4, ng = (v & 15) * 8; *(LAS u32x4*)(Bm + l * 144 + ng) = rb[q]; }
#pragma unroll
                for (int q = 0; q < 4; ++q) { const int v = t + q * 512, l = v >> 5, cg_ = (v & 31) * 8, h = cg_ >> 6;
                    float xv[8]; unpack8(rx[q], xv);
                    const float dt = dtsb[(cur * 4 + h) * 64 + l], de = __expf(acsb[(cur * 4 + h) * 64 + 63] - acsb[(cur * 4 + h) * 64 + l]);
#pragma unroll
                    for (int jj = 0; jj < 8; ++jj) xv[jj] *= dt;
                    u32x4 w;
                    if (PASSB) { w.x = pk2(xv[0], xv[1]); w.y = pk2(xv[2], xv[3]); w.z = pk2(xv[4], xv[5]); w.w = pk2(xv[6], xv[7]); *(LAS u32x4*)(X + l * 272 + cg_) = w; }
                    w.x = pk2(xv[0] * de, xv[1] * de); w.y = pk2(xv[2] * de, xv[3] * de); w.z = pk2(xv[4] * de, xv[5] * de); w.w = pk2(xv[6] * de, xv[7] * de); *(LAS u32x4*)(X2 + l * 272 + cg_) = w; }
                if (PASSB) {
#pragma unroll
                    for (int q = 0; q < 2; ++q) { const int v = t + q * 512, l = v >> 4, ng = (v & 15) * 8; *(LAS u32x4*)(Cm + l * 144 + ng) = rc[q]; } }
                if (st + 1 < nsteps) {
#pragma unroll
                    for (int q = 0; q < 2; ++q) { const int v = t + q * 512, l = v >> 4, ng = (v & 15) * 8; const int pos = dir ? L - 1 - (64 * (jd + 1) + l) : 64 * (jd + 1) + l;
                        const u16* rowp = act + (size_t)(seqrow0 + pos) * 4096; rb[q] = *(const u32x4*)(rowp + 2048 + grp * 128 + ng); }
#pragma unroll
                    for (int q = 0; q < 4; ++q) { const int v = t + q * 512, l = v >> 5, cg_ = (v & 31) * 8; const int pos = dir ? L - 1 - (64 * (jd + 1) + l) : 64 * (jd + 1) + l;
                        rx[q] = *(const u32x4*)(act + (size_t)(seqrow0 + pos) * 4096 + grp * 256 + cg_); }
                }
            }
            if (wid < 4 && st + 1 < nsteps) {
                const float dt = softplusf(dtp_n + dtb); const float ac = wave_cumsum(dt * Aneg, lane);
                dtsb[((cur ^ 1) * 4 + wid) * 64 + lane] = dt; acsb[((cur ^ 1) * 4 + wid) * 64 + lane] = ac; dsum += __shfl(ac, 63);
                if (st + 2 < nsteps) { const int pos2 = dir ? L - 1 - (64 * (jd + 2) + lane) : 64 * (jd + 2) + lane; dtp_n = bf2f(zd[(size_t)(seqrow0 + pos2) * ZDL + 2048 + dir * 32 + grp * 4 + wid]); } }
            __syncthreads();
            const LAS float* ac = acsb + (cur * 4 + hh) * 64;
            if (PASSB) {
#pragma unroll 1
                for (int rep_ = 0; rep_ < ((PROBE & 2048) ? 2 : 1); ++rep_) {
                    const int stile = wid >> 1;
                    f32x4 a2[2] = {(f32x4){0.f, 0.f, 0.f, 0.f}, (f32x4){0.f, 0.f, 0.f, 0.f}};
#pragma unroll
                    for (int kt = 0; kt < 4; ++kt) { const bf16x8 a = ldfrag(Bm, (16 * stile + fr) * 144 + kt * 32 + fq * 8);
#pragma unroll
                        for (int i = 0; i < 2; ++i) a2[i] = MFMA(a, ldfrag(Cm, (16 * (2 * (wid & 1) + i) + fr) * 144 + kt * 32 + fq * 8), a2[i]); }
#pragma unroll
                    for (int i = 0; i < 2; ++i) *(LAS f32x4*)(cbL + (16 * (2 * (wid & 1) + i) + fr) * 68 + 16 * stile + 4 * fq) = a2[i];
                }
                __syncthreads();
                auto ltbody = [&](const int lt, auto k1tag) {
                    constexpr bool K1 = decltype(k1tag)::value;
                    const int l = 16 * lt + fr; const float acl = ac[l];
                    asm volatile("" : "+v"(ST[0][0]), "+v"(ST[0][1]), "+v"(ST[0][2]), "+v"(ST[0][3]), "+v"(ST[0][4]), "+v"(ST[0][5]), "+v"(ST[0][6]), "+v"(ST[0][7]));
                    asm volatile("" : "+v"(ST[1][0]), "+v"(ST[1][1]), "+v"(ST[1][2]), "+v"(ST[1][3]), "+v"(ST[1][4]), "+v"(ST[1][5]), "+v"(ST[1][6]), "+v"(ST[1][7]));
                    bf16x8 cm[4], xa[2][2];
#pragma unroll
                    for (int kt = 0; kt < 4; ++kt) cm[kt] = ld_perm(Cm + l * 144, kt, fq);
#pragma unroll
                    for (int pi = 0; pi < 2; ++pi)
#pragma unroll
                        for (int kt = 0; kt < (K1 ? 2 : 1); ++kt) xa[pi][kt] = ld_tr(X, 272, 32 * kt + 4 * fq, 32 * kt + 16 + 4 * fq, 64 * hh + 16 * (pt0 + pi), lane);
                    bf16x8 pf[2];
#pragma unroll
                    for (int kt = 0; kt < (K1 ? 2 : 1); ++kt) { const int sA = 32 * kt + 4 * fq, sB = sA + 16;
                        const f32x4 ca = *(const LAS f32x4*)(cbL + l * 68 + sA), cb_ = *(const LAS f32x4*)(cbL + l * 68 + sB), aa = *(const LAS f32x4*)(ac + sA), ab = *(const LAS f32x4*)(ac + sB);
                        f32x4 ra, rb_;
#pragma unroll
                        for (int jj = 0; jj < 4; ++jj) { ra[jj] = (sA + jj <= l) ? ca[jj] * __expf(acl - aa[jj]) : 0.f; rb_[jj] = (sB + jj <= l) ? cb_[jj] * __expf(acl - ab[jj]) : 0.f; }
                        pf[kt] = pack_acc(ra, rb_); }
                    const float eacl = __expf(acl);
                    const int pos = dir ? L - 1 - (64 * jd + l) : 64 * jd + l;
                    f32x4 y0 = (f32x4){0.f, 0.f, 0.f, 0.f}, y1 = y0;
#pragma unroll
                    for (int kt = 0; kt < 4; ++kt) { y0 = MFMA(pack_acc(ST[0][2 * kt], ST[0][2 * kt + 1]), cm[kt], y0); y1 = MFMA(pack_acc(ST[1][2 * kt], ST[1][2 * kt + 1]), cm[kt], y1); }
                    y0 = y0 * eacl; y1 = y1 * eacl;
#pragma unroll
                    for (int kt = 0; kt < (K1 ? 2 : 1); ++kt) { y0 = MFMA(xa[0][kt], pf[kt], y0); y1 = MFMA(xa[1][kt], pf[kt], y1); }
                    { u32x2 w; w.x = pk2(y0[0], y0[1]); w.y = pk2(y0[2], y0[3]); *(u32x2*)(ydir + (size_t)(seqrow0 + pos) * 2048 + head * 64 + 16 * pt0 + 4 * fq) = w;
                      w.x = pk2(y1[0], y1[1]); w.y = pk2(y1[2], y1[3]); *(u32x2*)(ydir + (size_t)(seqrow0 + pos) * 2048 + head * 64 + 16 * (pt0 + 1) + 4 * fq) = w; }
                };
#pragma unroll 1
                for (int lt = 0; lt < 2; ++lt) ltbody(lt, std::false_type{});
#pragma unroll 1
                for (int lt = 2; lt < 4; ++lt) ltbody(lt, std::true_type{});
            }
            {
                const float dec = __expf(ac[63]);
#pragma unroll
                for (int pi = 0; pi < 2; ++pi) {
                    __builtin_amdgcn_sched_barrier(0);
                    const bf16x8 b0 = ld_tr(X2, 272, 8 * fq, 8 * fq + 4, 64 * hh + 16 * (pt0 + pi), lane), b1 = ld_tr(X2, 272, 32 + 8 * fq, 32 + 8 * fq + 4, 64 * hh + 16 * (pt0 + pi), lane);
#pragma unroll
                    for (int n = 0; n < 8; ++n) { ST[pi][n] = ST[pi][n] * dec;
                        ST[pi][n] = MFMA(ld_tr(Bm, 144, 8 * fq, 8 * fq + 4, 16 * n, lane), b0, ST[pi][n]); ST[pi][n] = MFMA(ld_tr(Bm, 144, 32 + 8 * fq, 32 + 8 * fq + 4, 16 * n, lane), b1, ST[pi][n]); }
                }
            }
            __syncthreads();
        }
        {
            float* sp = nullptr;
            if (!PASSB) { sp = segbuf + ((size_t)(chain * 7 + seg) * 4 + hh) * 8192; if (wid < 4 && lane == 0) dseg[(chain * 7 + seg) * 4 + wid] = dsum; }
            else if (!islat) sp = p.out + OUT_SSD + ((size_t)(((g * 16 + sig) * 2 + o) * 2 + dir) * 32 + head) * 8192;
            if (sp) {
#pragma unroll
                for (int pi = 0; pi < 2; ++pi)
#pragma unroll
                    for (int n = 0; n < 8; ++n) *(f32x4*)(sp + (16 * (pt0 + pi) + fr) * 128 + 16 * n + 4 * fq) = ST[pi][n];
            }
        }
    }
}
__device__ __forceinline__ void ph_ssdA(const Params& p, ldsp lds, int o, int g) { ssd_pass<false>(p, lds, o, g); }
__device__ __forceinline__ void ph_ssdB(const Params& p, ldsp lds, int o, int g) { ssd_pass<true>(p, lds, o, g); }
__device__ __forceinline__ void ph_ssdcomb(const Params& p, int o, int g) {
    float* segbuf = (float*)(p.ws + OD_SEG); const float* dseg = (const float*)(p.ws + OD_DSEG);
    for (int idx = blockIdx.x * NTHREADS + tid_opaque(); idx < 64 * 4 * 8192; idx += gridDim.x * NTHREADS) {
        const int chain = idx >> 15, h = (idx >> 13) & 3, el = idx & 8191; const int sig = chain >> 4, grp = (chain >> 1) & 7, dir = chain & 1;
        float cur = p.in[I_SSD][((size_t)(((g * 4 + sig) * 2 + o) * 2 + dir) * 32 + grp * 4 + h) * 8192 + el];
        float Lv[7], dv[7];
#pragma unroll
        for (int sg = 0; sg < 7; ++sg) { const int en = (chain * 7 + sg) * 4 + h; Lv[sg] = segbuf[(size_t)en * 8192 + el]; dv[sg] = dseg[en]; }
#pragma unroll
        for (int sg = 0; sg < 7; ++sg) { cur = __expf(dv[sg]) * cur + Lv[sg]; Lv[sg] = cur; }
#pragma unroll
        for (int sg = 0; sg < 7; ++sg) { const int en = (chain * 7 + sg) * 4 + h; segbuf[(size_t)en * 8192 + el] = Lv[sg]; }
    }
}
__device__ __forceinline__ void ph_ssdfin(const Params& p, int o) {
    const int t = tid_opaque(), wid = __builtin_amdgcn_readfirstlane(t >> 6), lane = t & 63;
    const u16* act = (const u16*)(p.ws + OD_ACT); const u16* zd = (const u16*)(p.ws + OD_ZD); u16* yf = (u16*)(p.ws + OD_YF); const u16* yb = (const u16*)(p.ws + OD_YB);
    const float* ng = p.in[I_SSDNG] + o * 2048; const float* Dh = p.in[I_SSDD] + o * 32;
    for (int r = blockIdx.x * 8 + wid; r < MG; r += gridDim.x * 8) {
        u32x4 ra[4], rb[4], rx[4], rz[4];
#pragma unroll
        for (int i = 0; i < 4; ++i) { const int c0 = i * 512 + lane * 8; ra[i] = *(const u32x4*)(yf + (size_t)r * 2048 + c0); rb[i] = *(const u32x4*)(yb + (size_t)r * 2048 + c0);
            rx[i] = *(const u32x4*)(act + (size_t)r * 4096 + c0); rz[i] = *(const u32x4*)(zd + (size_t)r * ZDL + c0); }
        float yv[4][8]; float ss = 0.f;
#pragma unroll
        for (int i = 0; i < 4; ++i) { const int c0 = i * 512 + lane * 8; float a[8], b[8], x[8], z[8]; unpack8(ra[i], a); unpack8(rb[i], b); unpack8(rx[i], x); unpack8(rz[i], z);
            const float dh = Dh[c0 >> 6];
#pragma unroll
            for (int j = 0; j < 8; ++j) { const float v = (a[j] + b[j] + dh * x[j]) * siluf(z[j]); yv[i][j] = v; ss += v * v; } }
#pragma unroll
        for (int q = 32; q > 0; q >>= 1) ss += __shfl_xor(ss, q);
        const float rstd = rsqrtf(ss * (1.0f / 2048.0f) + EPS);
#pragma unroll
        for (int i = 0; i < 4; ++i) { const int c0 = i * 512 + lane * 8; float gv[8]; ld8f(ng + c0, gv); u32x4 w;
            w.x = pk2(yv[i][0] * rstd * gv[0], yv[i][1] * rstd * gv[1]); w.y = pk2(yv[i][2] * rstd * gv[2], yv[i][3] * rstd * gv[3]);
            w.z = pk2(yv[i][4] * rstd * gv[4], yv[i][5] * rstd * gv[5]); w.w = pk2(yv[i][6] * rstd * gv[6], yv[i][7] * rstd * gv[7]);
            *(u32x4*)(yf + (size_t)r * 2048 + c0) = w; }
    }
}
#define XB_TMO      128
#define XB_XCNT(j)  (256  + 64 * (j))
#define XB_XSUB(j)  (1280 + 64 * (j))
#define XB_XGEN(j)  (2304 + 64 * (j))
#define XB_TOP      3328
#define XB_TOPGEN   3392
#define XCD_BAR_WORDS 3456
#define XB_SPIN_CAP (1u << 24)
__device__ __forceinline__ unsigned xb_ld(unsigned* p)              { return __hip_atomic_load(p, __ATOMIC_RELAXED, __HIP_MEMORY_SCOPE_AGENT); }
__device__ __forceinline__ unsigned xb_add(unsigned* p, unsigned v) { return __hip_atomic_fetch_add(p, v, __ATOMIC_RELAXED, __HIP_MEMORY_SCOPE_AGENT); }
__device__ __forceinline__ unsigned xb_xcc_id() { return (unsigned)__builtin_amdgcn_s_getreg((3 << 11) | 20) & 0xFu; }
#define XB_SPIN(cond, bar) do { unsigned _sp = 0; while (cond) { __builtin_amdgcn_s_sleep(1); \
    if ((++_sp & 255u) == 0u) { if (xb_ld(&(bar)[XB_TMO])) break; if (_sp > XB_SPIN_CAP) { atomicAdd(&(bar)[XB_TMO], 1u); break; } } } } while (0)
struct XcdBarrier { unsigned* bar; unsigned x; volatile LAS unsigned* st; };
__device__ __forceinline__ XcdBarrier xcd_barrier_post(unsigned* bar, volatile LAS unsigned* st) {
    XcdBarrier b; b.bar = bar; b.x = xb_xcc_id(); b.st = st;
    if (threadIdx.x == 0) (void)xb_add(&bar[XB_XCNT(b.x)], 1u);
    return b;
}
__device__ __forceinline__ void xcd_barrier_complete(unsigned* bar, unsigned x, unsigned& nloc, unsigned& nx) {
    const unsigned G = gridDim.x * gridDim.y * gridDim.z;
    unsigned sum, cnt, mine, sp = 0u;
    for (;;) {
        sum = 0u; cnt = 0u; mine = 0u;
#pragma unroll
        for (unsigned j = 0; j < 16; ++j) { const unsigned c = xb_ld(&bar[XB_XCNT(j)]); sum += c; cnt += (c > 0u) ? 1u : 0u; mine = (j == x) ? c : mine; }
        if (sum == G) break;
        __builtin_amdgcn_s_sleep(1);
        if ((++sp & 255u) == 0u) { if (xb_ld(&bar[XB_TMO])) break; if (sp > XB_SPIN_CAP) { atomicAdd(&bar[XB_TMO], 1u); break; } }
    }
    nloc = mine > 0u ? mine : 1u; nx = cnt > 0u ? cnt : 1u;
}
__device__ __forceinline__ void xcd_barrier(const XcdBarrier& b) {
    asm volatile("s_waitcnt vmcnt(0)" ::: "memory");
    __syncthreads();
    if (threadIdx.x == 0) {
        unsigned* bar = b.bar;
        __builtin_amdgcn_s_waitcnt(0);
        unsigned nloc = b.st[0], nx = b.st[1];
        if (nloc == 0u) { xcd_barrier_complete(bar, b.x, nloc, nx); b.st[0] = nloc; b.st[1] = nx; }
        const unsigned old = xb_add(&bar[XB_XSUB(b.x)], 1u);
        const unsigned gen = old / nloc;
        if (old + 1u == (gen + 1u) * nloc) {
            __builtin_amdgcn_fence(__ATOMIC_RELEASE, "agent");
            asm volatile("s_waitcnt vmcnt(0)" ::: "memory");
            const unsigned og = xb_add(&bar[XB_TOP], 1u);
            const unsigned tg = og / nx;
            if (og + 1u == (tg + 1u) * nx) xb_add(&bar[XB_TOPGEN], 1u);
            else XB_SPIN(xb_ld(&bar[XB_TOPGEN]) == tg, bar);
            __builtin_amdgcn_fence(__ATOMIC_ACQUIRE, "agent");
            xb_add(&bar[XB_XGEN(b.x)], 1u);
            asm volatile("s_waitcnt vmcnt(0)" ::: "memory");
        } else {
            XB_SPIN(xb_ld(&bar[XB_XGEN(b.x)]) == gen, bar);
            __builtin_amdgcn_fence(__ATOMIC_ACQUIRE, "agent");
            asm volatile("s_waitcnt vmcnt(0)" ::: "memory");
        }
    }
    __syncthreads();
}
__global__ void __launch_bounds__(NTHREADS, 2) fwd_megakernel(Params p) {
    extern __shared__ __attribute__((aligned(16))) unsigned char shm[];
    ldsp lds = (ldsp)shm;
    cg::grid_group grid = cg::this_grid();
    const float* mod = (const float*)(p.ws + WS_MOD);

    unsigned* bar_words = (unsigned*)(p.ws + WS_BAR);
    volatile LAS unsigned* bar_st = (volatile LAS unsigned*)(lds + LDS_BYTES - 16);
    if (blockIdx.x == 0) for (int i = threadIdx.x; i < XCD_BAR_WORDS; i += NTHREADS) __hip_atomic_store(bar_words + i, 0u, __ATOMIC_RELAXED, __HIP_MEMORY_SCOPE_AGENT);
    if (threadIdx.x < 2) bar_st[threadIdx.x] = 0u;
    __syncthreads();
    DUP(32, ph_modp(p, lds)); DUP(32, ph_wconv_layer(p, lds, 0)); DUP(32, ph_filt_raw(p, lds, 0));
    grid.sync();
    (void)xcd_barrier_post(bar_words, bar_st);
    ph_modfin(p); DUP(32, ph_filt_norm(p, lds));
    GSYNC();
    for (int l = 0; l < 4; ++l) {
        const int e = l >> 1; const bool even = (l & 1) == 0, colmajor = l >= 2;
        if (l > 0) { DUP(32, ph_wconv_layer(p, lds, l)); if (l == 2) DUP(32, ph_filt_raw(p, lds, 1)); GSYNC(); }
        for (int g = 0; g < NG; ++g) {
            if (even) {
                DUP(16, ph_norm(p, l, 0, true, g, colmajor, (u16*)(p.ws + EV_H))); if (l == 2 && g == 0) DUP(32, ph_filt_norm(p, lds));
                GSYNC();
                { EpiProjEven E; E.projT = (u16*)(p.ws + EV_PROJT); E.projR = (u16*)(p.ws + EV_PROJR); DUP(2, run_gemm(lds, (const u16*)(p.ws + EV_H), (const u16*)(p.ws + WT_IN), MG, EVPAD, 1024, E)); }
                GSYNC();
                DUP(256, ph_mlact(p, e));
                GSYNC();
                DUP(4, ph_mlA(p, lds, e)); DUP(8, ph_hyena(p, lds, e));
                GSYNC();
                ph_mlB(p, e, g); DUP(256, ph_hytrans(p, lds, g));
                GSYNC();
                DUP(4, ph_mlC(p, lds, e, g));
                GSYNC();
                if (g == NG - 1) {
                    { EpiResid E; E.x = p.out; E.mod = mod; E.l = l; E.gidx = 2; E.g = 0; E.colmajor = colmajor; E.grouped = true; E.first = (l == 0); E.xp0 = p.in[I_XP]; E.xs0 = p.in[I_XS]; run_gemm(lds, (const u16*)(p.ws + EV_Y), (const u16*)(p.ws + WT_OUT), 2 * MG, 1024, 1024, E); }
                    GSYNC();
                }
            } else {
                if (g == 0) { DUP(16, ph_norm(p, l, 0, true, g, colmajor, (u16*)(p.ws + OD_H))); GSYNC(); }
                { EpiProjOdd E; E.zd = (u16*)(p.ws + OD_ZD); E.raw = (u16*)(p.ws + OD_RAW); DUP(2, run_gemm(lds, (const u16*)(p.ws + OD_H), (const u16*)(p.ws + WT_IN), MG, ODPAD, 1024, E)); }
                GSYNC();
                DUP(256, ph_ssdact(p, e));
                GSYNC();
                DUP(1, ph_ssdA(p, lds, e, g));
                GSYNC();
                ph_ssdcomb(p, e, g);
                GSYNC();
                DUP(1, ph_ssdB(p, lds, e, g));
                GSYNC();
                ph_ssdfin(p, e);
                GSYNC();
                { EpiResid E; E.x = p.out; E.mod = mod; E.l = l; E.gidx = 2; E.g = g; E.colmajor = colmajor; E.grouped = true; E.first = (l == 0); E.xp0 = p.in[I_XP]; E.xs0 = p.in[I_XS]; run_gemm(lds, (const u16*)(p.ws + OD_YF), (const u16*)(p.ws + WT_OUT), MG, 1024, 2048, E); }
                if (g == 0) { const int nb = (int)gridDim.x, two = (MG / 256) * 4 - nb;
                    if (two > 0 && two < nb) ph_norm(p, l, 0, true, 1, colmajor, (u16*)(p.ws + OD_H), two, nb - two); else ph_norm(p, l, 0, true, 1, colmajor, (u16*)(p.ws + OD_H)); }
                else { const int nb = (int)gridDim.x, two = (MG / 256) * 4 - nb;
                    if (two > 0 && two < nb) ph_norm(p, l, 1, true, 0, false, (u16*)(p.ws + FF_H), two, nb - two, true); else ph_norm(p, l, 1, true, 0, false, (u16*)(p.ws + FF_H), 0, 0, true); }
                GSYNC();
            }
        }
        if (even) { DUP(16, ph_norm(p, l, 1, false, 0, false, (u16*)(p.ws + FF_H))); } else ph_norm(p, l, 1, true, 1, false, (u16*)(p.ws + FF_H), 0, 0, true);
        GSYNC();
        { EpiSwiGLU E; E.uo = (u16*)(p.ws + FF_U); DUP(2, run_gemm(lds, (const u16*)(p.ws + FF_H), (const u16*)(p.ws + WT_F13), NTOK, 2 * FH, 1024, E)); }
        GSYNC();
        { EpiResid E; E.x = p.out; E.mod = mod; E.l = l; E.gidx = 5; E.g = 0; E.colmajor = false; E.grouped = false; E.first = false; E.xp0 = p.in[I_XP]; E.xs0 = p.in[I_XS]; run_gemm(lds, (const u16*)(p.ws + FF_U), (const u16*)(p.ws + WT_F2), NTOK, 1024, FH, E); }
        GSYNC();
    }
    ph_final(p);
}

extern "C" void kernel_launch(void* const* d_in, const int* in_sizes, int n_in, void* d_out, int out_size, void* d_ws, size_t ws_size, hipStream_t stream) {
    static int grid_blocks = 0;
    if (!grid_blocks) {
        int dev = 0, cus = 0, per_cu = 0;
        hipGetDevice(&dev);
        hipDeviceGetAttribute(&cus, hipDeviceAttributeMultiprocessorCount, dev);
        hipFuncSetAttribute((const void*)fwd_megakernel, hipFuncAttributeMaxDynamicSharedMemorySize, LDS_BYTES);
        hipOccupancyMaxActiveBlocksPerMultiprocessor(&per_cu, (const void*)fwd_megakernel, NTHREADS, LDS_BYTES);
        if (per_cu < 1) per_cu = 1;
        grid_blocks = cus * per_cu;
        if (ws_size < 504 * MiB) fprintf(stderr, "kernel_launch: workspace too small: %zu\n", ws_size);
    }
    Params p{};
    for (int i = 0; i < 37; ++i) p.in[i] = (const float*)d_in[i];
    p.out = (float*)d_out; p.ws = (unsigned char*)d_ws;
    void* args[] = {&p};
    hipError_t er = hipLaunchCooperativeKernel((const void*)fwd_megakernel, dim3(grid_blocks), dim3(NTHREADS), args, LDS_BYTES, stream);
    if (er != hipSuccess) fprintf(stderr, "cooperative launch failed: %s (grid %d)\n", hipGetErrorString(er), grid_blocks);
}
```

```cpp
#include <hip/hip_runtime.h>
#ifndef PROBE
#define PROBE 0
#endif
#define DUP(bit, stmt) do { stmt; if (PROBE & (bit)) { stmt; } } while (0)
#define GSYNC() do { unsigned* bw_ = (unsigned*)(p.ws + WS_BAR); asm volatile("" : "+s"(bw_)); XcdBarrier b_; b_.bar = bw_; b_.x = xb_xcc_id(); b_.st = (volatile LAS unsigned*)(lds + LDS_BYTES - 16); xcd_barrier(b_); if (PROBE & 128) xcd_barrier(b_); } while (0)
#include <hip/hip_cooperative_groups.h>
#include <cstdio>
#include <type_traits>
namespace cg = cooperative_groups;

#define LAS __attribute__((address_space(3)))
typedef unsigned short u16;
typedef short bf16x8 __attribute__((ext_vector_type(8)));
typedef float f32x4 __attribute__((ext_vector_type(4)));
typedef unsigned u32x4 __attribute__((ext_vector_type(4)));
typedef unsigned u32x2 __attribute__((ext_vector_type(2)));
typedef LAS unsigned char* ldsp;

constexpr int D = 1024, NCTX = 8192, NLAT = 32768, NTOK = 40960;
constexpr int NG = 2, CTXG = 4096, LATG = 16384, MG = 20480;
constexpr int EVP = 3600, EVPAD = 3840, EVR = 2064  , ODP = 6208, ODPAD = 6400, FH = 2816;
constexpr int NTHREADS = 512;
constexpr int LDS_BYTES = 160 * 1024;
constexpr float EPS = 1e-6f;

constexpr size_t OUT_C = 41943040ull, OUT_N = 50331648ull, OUT_M = 50397184ull, OUT_SSD = 50397696ull;

constexpr size_t MiB = 1048576ull;
constexpr size_t WS_MODP = 0, WS_MOD = 4 * MiB, WS_NST = 5 * MiB, WS_SC = 7 * MiB, WS_BAR = 7 * MiB + 512 * 1024, WS_MSC = 7 * MiB + 256 * 1024;
constexpr size_t WS_WT = 8 * MiB, WT_IN = WS_WT, WT_OUT = WS_WT + 13 * MiB, WT_F13 = WS_WT + 17 * MiB, WT_F2 = WS_WT + 28 * MiB;
constexpr size_t WS_KERNL = 44 * MiB, WS_KERNC = 77 * MiB;
constexpr size_t EV_H = 80 * MiB, EV_PROJT = 120 * MiB, EV_PROJR = 180 * MiB, EV_Y = 261 * MiB, EV_ST = 341 * MiB;
constexpr size_t EV_RAWL = 421 * MiB, EV_RAWC = 453 * MiB, EV_FSUM = 456 * MiB, EV_YT = 458 * MiB;
constexpr size_t OD_H = 44 * MiB, OD_SEG = 44 * MiB, OD_ZD = 100 * MiB, OD_RAW = 183 * MiB, OD_YF = 183 * MiB, OD_YB = 263 * MiB, OD_ACT = 343 * MiB, OD_DSEG = WS_NST;
constexpr int ZDL = 2112;
constexpr size_t FF_H = 44 * MiB, FF_U = 124 * MiB;

struct Params { const float* in[37]; float* out; unsigned char* ws; };
enum { I_XP = 0, I_XS, I_SC, I_SN, I_SM, I_SSD, I_C, I_CCTX, I_MODW, I_MODB, I_N1G, I_N2G, I_W1, I_W3, I_W2, I_FG, I_EVIN, I_EVCW, I_EVCB,
       I_HW1, I_HB1, I_HW2, I_HB2, I_HW3, I_HFREQ, I_HBIAS, I_MGB, I_MNG, I_EVOUT, I_ODIN, I_ODCW, I_ODCB, I_DTB, I_ALOG, I_SSDD, I_SSDNG, I_ODOUT };

typedef float f32x2 __attribute__((ext_vector_type(2)));
typedef __bf16 bf16x2_t __attribute__((ext_vector_type(2)));
__device__ __forceinline__ u16 f2bf(float f) { const __bf16 h = (__bf16)f; return __builtin_bit_cast(u16, h); }
__device__ __forceinline__ float bf2f(u16 b) { return __uint_as_float(((unsigned)b) << 16); }
__device__ __forceinline__ unsigned pk2(float a, float b) { const f32x2 v = {a, b}; const bf16x2_t r = __builtin_convertvector(v, bf16x2_t); return __builtin_bit_cast(unsigned, r); }
__device__ __forceinline__ float siluf(float x) { return x * __builtin_amdgcn_rcpf(1.0f + __expf(-x)); }
__device__ __forceinline__ float sigmf(float x) { return __builtin_amdgcn_rcpf(1.0f + __expf(-x)); }
__device__ __forceinline__ float softplusf(float x) { return fmaxf(x, 0.f) + __logf(1.0f + __expf(-fabsf(x))); }
__device__ __forceinline__ float logsigf(float x) { return fminf(x, 0.f) - __logf(1.0f + __expf(-fabsf(x))); }
__device__ __forceinline__ void unpack8(u32x4 v, float* f) {
    f[0] = __uint_as_float(v.x << 16); f[1] = __uint_as_float(v.x & 0xffff0000u); f[2] = __uint_as_float(v.y << 16); f[3] = __uint_as_float(v.y & 0xffff0000u);
    f[4] = __uint_as_float(v.z << 16); f[5] = __uint_as_float(v.z & 0xffff0000u); f[6] = __uint_as_float(v.w << 16); f[7] = __uint_as_float(v.w & 0xffff0000u); }
__device__ __forceinline__ void ld8(const u16* p, float* f) { unpack8(*(const u32x4*)p, f); }
__device__ __forceinline__ void ld8f(const float* p, float* f) { f32x4 a = *(const f32x4*)p, b = *(const f32x4*)(p + 4); f[0]=a[0];f[1]=a[1];f[2]=a[2];f[3]=a[3];f[4]=b[0];f[5]=b[1];f[6]=b[2];f[7]=b[3]; }
__device__ __forceinline__ void conv8(const u16* rowp, int ld, bool hasPrev, bool hasNext, const float* w, int cw, const float* b, int ci, float* out) {
    float p0[8], pm[8], pp[8], w0[8], w1[8], w2[8], bb[8];
    ld8(rowp, p0);
    if (hasPrev) ld8(rowp - ld, pm); else { for (int j = 0; j < 8; ++j) pm[j] = 0.f; }
    if (hasNext) ld8(rowp + ld, pp); else { for (int j = 0; j < 8; ++j) pp[j] = 0.f; }
    ld8f(w + ci, w0); ld8f(w + cw + ci, w1); ld8f(w + 2 * cw + ci, w2); ld8f(b + ci, bb);
#pragma unroll
    for (int j = 0; j < 8; ++j) out[j] = bb[j] + w0[j] * pm[j] + w1[j] * p0[j] + w2[j] * pp[j];
}
__device__ __forceinline__ bf16x8 ldfrag(const LAS u16* base, int off) { return *(const LAS bf16x8*)(base + off); }
#define MFMA(a, b, c) __builtin_amdgcn_mfma_f32_16x16x32_bf16((a), (b), (c), 0, 0, 0)

__device__ __forceinline__ int tid_opaque() { int t; asm volatile("v_mov_b32 %0, %1" : "=v"(t) : "v"((int)threadIdx.x)); return t; }
__device__ __forceinline__ int grow_of(int g, int r) { return r < CTXG ? g * CTXG + r : NCTX + g * LATG + (r - CTXG); }
__device__ __forceinline__ int cond_of(int g, int r) { return r < CTXG ? 0 : 1 + g * 4 + ((r - CTXG) >> 12); }
__device__ __forceinline__ int cond_of_global(int gr) { return gr < NCTX ? 0 : 1 + ((gr - NCTX) >> 12); }
__device__ __forceinline__ int perm_row(int r, bool colmajor) {
    if (!colmajor || r < CTXG) return r;
    const int q = r - CTXG, s = q >> 12, i = q & 4095;
    return CTXG + (s << 12) + ((i & 63) << 6) + (i >> 6);
}

namespace pg8 {
constexpr int BM = 256, BK = 64, HALF = 128, HTB = HALF * BK * 2, STAGE_BYTES = 8 * HTB, NXCD = 8, WGM = 8;
__device__ __forceinline__ int lds_byte(int r, int c) { const int st = (r >> 4) * 2 + (c >> 5), rr = r & 15, cc = c & 31, ob = rr * 64 + cc * 2; return st * 1024 + (ob ^ (((ob >> 9) & 1) << 5)); }
__device__ __forceinline__ void stage_rc(int b, int& R, int& C) { const int st = b / 1024, sb = b % 1024, swz = sb ^ (((sb >> 9) & 1) << 5); R = (st >> 1) * 16 + swz / 64; C = (st & 1) * 32 + (swz % 64) / 2; }
struct Unit { int pm, pn; };
struct Gemm { const u16* A; const u16* Bt; int M, N, K; };
struct StaticOrder {
    int nM, nN, nwg, G, c;
    __device__ void init(int M, int N, int G_, int c_) { nM = M / BM; nN = N / BM; nwg = nM * nN; G = G_; c = c_; }
    __device__ bool next(int i, Unit& u) const {
        const long L = (long)i * G + c; if (L >= nwg) return false;
        int wgid = (int)L; { const int q = nwg / NXCD, r = nwg % NXCD, xcd = wgid % NXCD, off = wgid / NXCD; wgid = (xcd < r ? xcd * (q + 1) : r * (q + 1) + (xcd - r) * q) + off; }
        const int nig = WGM * nN, gid = wgid / nig, fm = gid * WGM, gsz = (nM - fm) < WGM ? (nM - fm) : WGM;
        u.pm = fm + ((wgid % nig) % gsz); u.pn = (wgid % nig) / gsz; return true;
    }
};
template <class Epi>
__device__ __forceinline__ void gemm_phase(ldsp lds, const Gemm g, const StaticOrder& S, const Epi& E) {
    const int tid = tid_opaque(), wid = __builtin_amdgcn_readfirstlane(tid >> 6), lane = tid & 63, wr = wid >> 2, wc = wid & 3, fr = lane & 15, fq = lane >> 4;
    const int K = g.K, nt = K / BK;
    unsigned voffA[2];
#pragma unroll
    for (int i = 0; i < 2; ++i) { int R, C; stage_rc(tid * 16 + i * 8192, R, C); voffA[i] = (unsigned)(R * K + C) * 2u; }
    const size_t kstep = (size_t)(BK * 2);
    const size_t hstep = (size_t)HALF * K * 2;
    const size_t tstep = 2 * hstep;
    const unsigned ldsw = (unsigned)wid * 1024u;
    const int aoff = lds_byte(wr * 64 + fr, fq * 8), boff = lds_byte(wc * 32 + fr, fq * 8);
#define PG8_SA(b, h) (((b) * 2 + (h)) * HTB)
#define PG8_SB(b, h) ((4 + (b) * 2 + (h)) * HTB)
#define PG8_STAGE(bufoff, gbase, voff) do { _Pragma("unroll") for (int _i = 0; _i < 2; ++_i) \
        __builtin_amdgcn_global_load_lds((const unsigned*)((const char*)(gbase) + (voff)[_i]), (LAS unsigned*)(lds + (bufoff) + ldsw + _i * 8192), 16, 0, 0); } while (0)
#define PG8_LDA(dst, b, h) do { _Pragma("unroll") for (int m = 0; m < 4; ++m) _Pragma("unroll") for (int k = 0; k < 2; ++k) dst[m][k] = *(const LAS bf16x8*)(lds + PG8_SA(b, h) + aoff + m * 2048 + k * 1024); } while (0)
#define PG8_LDB(dst, b, h) do { _Pragma("unroll") for (int n = 0; n < 2; ++n) _Pragma("unroll") for (int k = 0; k < 2; ++k) dst[n][k] = *(const LAS bf16x8*)(lds + PG8_SB(b, h) + boff + n * 2048 + k * 1024); } while (0)
#define PG8_MMA(ai, bj, At, Bt) do { __builtin_amdgcn_s_setprio(1); _Pragma("unroll") for (int m = 0; m < 4; ++m) _Pragma("unroll") for (int n = 0; n < 2; ++n) _Pragma("unroll") for (int k = 0; k < 2; ++k) \
        acc[ai][bj][m][n] = __builtin_amdgcn_mfma_f32_16x16x32_bf16(Bt[n][k], At[m][k], acc[ai][bj][m][n], 0, 0, 0); __builtin_amdgcn_s_setprio(0); } while (0)
#define PG8_WAIT_V(n) asm volatile("s_waitcnt vmcnt(" #n ")" ::: "memory")
#define PG8_WAIT_L(n) asm volatile("s_waitcnt lgkmcnt(" #n ")" ::: "memory")
#define PG8_BAR __builtin_amdgcn_s_barrier()
#define PG8_SCHED __builtin_amdgcn_sched_barrier(0)
    Unit cur, nxt; int ui = 0;
    if (!S.next(0, cur)) return;
    f32x4 acc[2][2][4][2];
#pragma unroll
    for (int a = 0; a < 2; ++a)
#pragma unroll
        for (int b = 0; b < 2; ++b)
#pragma unroll
            for (int m = 0; m < 4; ++m)
#pragma unroll
                for (int n = 0; n < 2; ++n) acc[a][b][m][n] = (f32x4){0.f, 0.f, 0.f, 0.f};
    bf16x8 At[4][2], B0[2][2], B1[2][2];
    const char* cA = (const char*)g.A + (size_t)cur.pm * tstep; const char* cB = (const char*)g.Bt + (size_t)cur.pn * tstep;
    PG8_STAGE(PG8_SB(0, 0), cB, voffA); PG8_STAGE(PG8_SA(0, 0), cA, voffA); PG8_STAGE(PG8_SB(0, 1), cB + hstep, voffA); PG8_STAGE(PG8_SA(0, 1), cA + hstep, voffA);
    if (wr == 1) PG8_BAR;
    PG8_WAIT_V(4); PG8_BAR;
    PG8_STAGE(PG8_SB(1, 0), cB + kstep, voffA); PG8_STAGE(PG8_SA(1, 0), cA + kstep, voffA); PG8_STAGE(PG8_SB(1, 1), cB + hstep + kstep, voffA);
    PG8_WAIT_V(6); PG8_BAR;
    for (;;) {
        const bool has_next = S.next(ui + 1, nxt);
        const char* nA = has_next ? (const char*)g.A + (size_t)nxt.pm * tstep : cA; const char* nB = has_next ? (const char*)g.Bt + (size_t)nxt.pn * tstep : cB;
        for (int t = 0; t < nt; t += 2) {
            const bool last = (t == nt - 2);
            const char* a1 = cA + (size_t)(t + 1) * kstep;
            const char* a2 = last ? nA : cA + (size_t)(t + 2) * kstep; const char* b2 = last ? nB : cB + (size_t)(t + 2) * kstep;
            const char* a3 = a2 + kstep; const char* b3 = b2 + kstep;
            PG8_LDB(B0, 0, 0); PG8_SCHED; PG8_LDA(At, 0, 0); PG8_STAGE(PG8_SA(1, 1), a1 + hstep, voffA);
            PG8_WAIT_L(8); PG8_BAR; PG8_WAIT_L(0); PG8_MMA(0, 0, At, B0); PG8_BAR; PG8_SCHED;
            PG8_LDB(B1, 0, 1); PG8_STAGE(PG8_SB(0, 0), b2, voffA);
            PG8_BAR; PG8_WAIT_L(0); PG8_MMA(0, 1, At, B1); PG8_BAR;
            PG8_LDA(At, 0, 1); PG8_STAGE(PG8_SA(0, 0), a2, voffA);
            PG8_BAR; PG8_WAIT_L(0); PG8_MMA(1, 0, At, B0); PG8_BAR; PG8_SCHED;
            PG8_STAGE(PG8_SB(0, 1), b2 + hstep, voffA);
            PG8_WAIT_V(6); PG8_BAR; PG8_MMA(1, 1, At, B1); PG8_BAR;
            PG8_LDB(B0, 1, 0); PG8_SCHED; PG8_LDA(At, 1, 0); PG8_STAGE(PG8_SA(0, 1), a2 + hstep, voffA);
            PG8_WAIT_L(8); PG8_BAR; PG8_WAIT_L(0); PG8_MMA(0, 0, At, B0); PG8_BAR; PG8_SCHED;
            PG8_LDB(B1, 1, 1); PG8_STAGE(PG8_SB(1, 0), b3, voffA);
            PG8_BAR; PG8_WAIT_L(0); PG8_MMA(0, 1, At, B1); PG8_BAR;
            PG8_LDA(At, 1, 1); PG8_STAGE(PG8_SA(1, 0), a3, voffA);
            PG8_BAR; PG8_WAIT_L(0); PG8_MMA(1, 0, At, B0); PG8_BAR; PG8_SCHED;
            PG8_STAGE(PG8_SB(1, 1), b3 + hstep, voffA);
            PG8_WAIT_V(6); PG8_BAR; PG8_MMA(1, 1, At, B1); PG8_BAR;
        }
        E(acc, cur, wr, wc, fr, fq);
        if (!has_next) break;
#pragma unroll
        for (int a = 0; a < 2; ++a)
#pragma unroll
            for (int b = 0; b < 2; ++b)
#pragma unroll
                for (int m = 0; m < 4; ++m)
#pragma unroll
                    for (int n = 0; n < 2; ++n) acc[a][b][m][n] = (f32x4){0.f, 0.f, 0.f, 0.f};
        cur = nxt; cA = nA; cB = nB; ++ui;
    }
    PG8_WAIT_V(0);
    if (wr == 0) PG8_BAR;
    PG8_BAR;
#undef PG8_SA
#undef PG8_SB
#undef PG8_STAGE
#undef PG8_LDA
#undef PG8_LDB
#undef PG8_MMA
#undef PG8_WAIT_V
#undef PG8_WAIT_L
#undef PG8_BAR
#undef PG8_SCHED
}
}

typedef const f32x4 (&AccRef)[2][2][4][2];
#define EPI_LOOP_BEGIN \
    _Pragma("unroll") for (int ai = 0; ai < 2; ++ai) _Pragma("unroll") for (int m = 0; m < 4; ++m) { const int row = u.pm * 256 + ai * 128 + wr * 64 + m * 16 + fr;
#define EPI_COLS_BEGIN \
    _Pragma("unroll") for (int bj = 0; bj < 2; ++bj) _Pragma("unroll") for (int n = 0; n < 2; ++n) { const int col = u.pn * 256 + bj * 128 + wc * 32 + n * 16 + 4 * fq; const f32x4 v = acc[ai][bj][m][n];

struct EpiProjEven {
    u16* projT; u16* projR;
    __device__ __forceinline__ void operator()(AccRef acc, const pg8::Unit& u, int wr, int wc, int fr, int fq) const {
        EPI_LOOP_BEGIN EPI_COLS_BEGIN
            if (col < 1536) {
#pragma unroll
                for (int j = 0; j < 4; ++j) projT[(size_t)(col + j) * MG + row] = f2bf(v[j]);
            } else if (col < EVP) {
                u32x2 w; w.x = pk2(v[0], v[1]); w.y = pk2(v[2], v[3]);
                *(u32x2*)(projR + (size_t)row * EVR + (col - 1536)) = w;
            }
        } }
    }
};
struct EpiProjOdd {
    u16* zd; u16* raw;
    __device__ __forceinline__ void operator()(AccRef acc, const pg8::Unit& u, int wr, int wc, int fr, int fq) const {
        EPI_LOOP_BEGIN EPI_COLS_BEGIN
            u32x2 w; w.x = pk2(v[0], v[1]); w.y = pk2(v[2], v[3]);
            if (col < 2048) *(u32x2*)(zd + (size_t)row * ZDL + col) = w;
            else if (col < 6144) *(u32x2*)(raw + (size_t)row * 4096 + (col - 2048)) = w;
            else if (col < ODP) *(u32x2*)(zd + (size_t)row * ZDL + 2048 + (col - 6144)) = w;
        } }
    }
};
struct EpiResid {
    float* x; const float* mod; const float* xp0; const float* xs0; int l, gidx, g; bool colmajor, grouped, first;
    __device__ __forceinline__ void operator()(AccRef acc, const pg8::Unit& u, int wr, int wc, int fr, int fq) const {
        EPI_LOOP_BEGIN
            int grow, cond;
            if (grouped) { const int gg = g + (row >= MG ? 1 : 0); const int r = perm_row(row >= MG ? row - MG : row, colmajor); grow = grow_of(gg, r); cond = cond_of(gg, r); }
            else { grow = row; cond = cond_of_global(row); }
            const float* gp = mod + ((size_t)(l * 9 + cond) * 6 + gidx) * 1024;
            float* xp = x + (size_t)grow * 1024;
            const float* xi = first ? (grow < NCTX ? xp0 + (size_t)grow * 1024 : xs0 + (size_t)(grow - NCTX) * 1024) : xp;
            EPI_COLS_BEGIN
                const f32x4 gt = *(const f32x4*)(gp + col); f32x4 xv = *(const f32x4*)(xi + col);
                xv = xv + gt * v; *(f32x4*)(xp + col) = xv;
            }
        }
    }
};
struct EpiSwiGLU {
    u16* uo;
    __device__ __forceinline__ void operator()(AccRef acc, const pg8::Unit& u, int wr, int wc, int fr, int fq) const {
        EPI_LOOP_BEGIN
#pragma unroll
            for (int bj = 0; bj < 2; ++bj) {
                const int hc = (u.pn * 256 + bj * 128 + wc * 32) / 2 + 4 * fq;
                const f32x4 a = acc[ai][bj][m][0], b = acc[ai][bj][m][1];
                u32x2 w; w.x = pk2(siluf(a[0]) * b[0], siluf(a[1]) * b[1]); w.y = pk2(siluf(a[2]) * b[2], siluf(a[3]) * b[3]);
                *(u32x2*)(uo + (size_t)row * FH + hc) = w;
            }
        }
    }
};

template <class Epi>
__device__ __forceinline__ void run_gemm(ldsp lds, const u16* A, const u16* Bt, int M, int N, int K, const Epi& E) {
    pg8::Gemm g; g.A = A; g.Bt = Bt; g.M = M; g.N = N; g.K = K;
    pg8::StaticOrder S; S.init(M, N, (int)gridDim.x, (int)blockIdx.x);
    pg8::gemm_phase<Epi>(lds, g, S, E);
}

__device__ __forceinline__ void ph_copyx(const Params& p) {
    const f32x4* a = (const f32x4*)p.in[I_XP]; const f32x4* b = (const f32x4*)p.in[I_XS]; f32x4* o = (f32x4*)p.out;
    const size_t n0 = (size_t)NCTX * 256, n1 = (size_t)NTOK * 256;
    for (size_t i = (size_t)blockIdx.x * NTHREADS + tid_opaque(); i < n1; i += (size_t)gridDim.x * NTHREADS) o[i] = i < n0 ? a[i] : b[i - n0];
}
__device__ __forceinline__ void ph_modp(const Params& p, ldsp lds) {
    LAS float* s = (LAS float*)lds;
    float* modp = (float*)(p.ws + WS_MODP);
    const int t = tid_opaque();
    for (int it = blockIdx.x; it < 192; it += gridDim.x) {
        const int l = it / 48, rem = it % 48, cc = rem >> 2, ks = rem & 3;
        __syncthreads();
        for (int idx = t; idx < 9 * 256; idx += NTHREADS) { const int r = idx >> 8, k = idx & 255;
            const float cv = r == 0 ? p.in[I_CCTX][ks * 256 + k] : p.in[I_C][(r - 1) * 1024 + ks * 256 + k]; s[idx] = siluf(cv); }
        __syncthreads();
        const int col = cc * 512 + t;
        float acc[9];
#pragma unroll
        for (int r = 0; r < 9; ++r) acc[r] = 0.f;
        const float* w = p.in[I_MODW] + ((size_t)l * 1024 + ks * 256) * 6144 + col;
#pragma unroll 8
        for (int k = 0; k < 256; ++k) { const float wv = w[(size_t)k * 6144];
#pragma unroll
            for (int r = 0; r < 9; ++r) acc[r] += s[r * 256 + k] * wv; }
#pragma unroll
        for (int r = 0; r < 9; ++r) modp[((size_t)(ks * 4 + l) * 9 + r) * 6144 + col] = acc[r];
    }
}
__device__ __forceinline__ void ph_modfin(const Params& p) {
    const float* modp = (const float*)(p.ws + WS_MODP); float* mod = (float*)(p.ws + WS_MOD);
    for (int idx = blockIdx.x * NTHREADS + tid_opaque(); idx < 221184; idx += gridDim.x * NTHREADS) {
        const int l = idx / (9 * 6144), col = idx % 6144;
        mod[idx] = modp[idx] + modp[221184 + idx] + modp[2 * 221184 + idx] + modp[3 * 221184 + idx] + p.in[I_MODB][l * 6144 + col];
    }
}
__device__ __forceinline__ void ph_wconv(ldsp lds, const float* src, const float* src2, int K, int Nsrc, int Npad, int mode, u16* dst) {
    const int t = tid_opaque(), wid = __builtin_amdgcn_readfirstlane(t >> 6), lane = t & 63, nkt = K / 64, ntiles = (Npad / 64) * nkt;
    for (int it = blockIdx.x; it < ntiles; it += gridDim.x) {
        const int n = (it / nkt) * 64 + 8 * wid + (lane >> 3), k = (it % nkt) * 64 + (lane & 7) * 8;
        const float* sp; int sc; bool valid = true;
        if (mode == 0) { sp = src; sc = n; valid = n < Nsrc; } else { sp = ((n >> 4) & 1) ? src2 : src; sc = (n >> 5) * 16 + (n & 15); }
        float v[8];
#pragma unroll
        for (int j = 0; j < 8; ++j) v[j] = valid ? sp[(size_t)(k + j) * Nsrc + sc] : 0.f;
        u32x4 w; w.x = pk2(v[0], v[1]); w.y = pk2(v[2], v[3]); w.z = pk2(v[4], v[5]); w.w = pk2(v[6], v[7]);
        *(u32x4*)(dst + (size_t)n * K + k) = w;
    }
}
__device__ __forceinline__ void ph_wconv_layer(const Params& p, ldsp lds, int l) {
    const int e = l >> 1;
    if ((l & 1) == 0) {
        ph_wconv(lds, p.in[I_EVIN] + (size_t)e * 1024 * EVP, nullptr, 1024, EVP, EVPAD, 0, (u16*)(p.ws + WT_IN));
        ph_wconv(lds, p.in[I_EVOUT] + (size_t)e * 1024 * 1024, nullptr, 1024, 1024, 1024, 0, (u16*)(p.ws + WT_OUT));
    } else {
        ph_wconv(lds, p.in[I_ODIN] + (size_t)e * 1024 * ODP, nullptr, 1024, ODP, ODPAD, 0, (u16*)(p.ws + WT_IN));
        ph_wconv(lds, p.in[I_ODOUT] + (size_t)e * 2048 * 1024, nullptr, 2048, 1024, 1024, 0, (u16*)(p.ws + WT_OUT));
    }
    ph_wconv(lds, p.in[I_W1] + (size_t)l * 1024 * FH, p.in[I_W3] + (size_t)l * 1024 * FH, 1024, FH, 2 * FH, 1, (u16*)(p.ws + WT_F13));
    ph_wconv(lds, p.in[I_W2] + (size_t)l * FH * 1024, nullptr, FH, 1024, 1024, 0, (u16*)(p.ws + WT_F2));
}

__device__ __forceinline__ void ph_filt_raw(const Params& p, ldsp lds, int e) {
    LAS float* h1 = (LAS float*)lds; LAS float* h2 = h1 + 64 * 65; LAS float* ft = h2 + 64 * 65;
    const int t = tid_opaque(), pos = t & 63, jg = t >> 6;
    const float* w1 = p.in[I_HW1] + e * 33 * 64; const float* b1 = p.in[I_HB1] + e * 64; const float* w2 = p.in[I_HW2] + e * 64 * 64; const float* b2 = p.in[I_HB2] + e * 64;
    const float* w3 = p.in[I_HW3] + (size_t)e * 64 * 2048; const float* fr = p.in[I_HFREQ] + e * 64;
    for (int it4 = blockIdx.x; it4 < 272; it4 += gridDim.x) {
        const int it = it4 >> 2, ci = it4 & 3;
        const bool isc = it < 4; const int L = isc ? 256 : 4096, lb = isc ? it : it - 4;
        float* raw = (float*)(p.ws + (isc ? EV_RAWC : EV_RAWL));
        const float invLm1 = 1.0f / (float)(L - 1);
        __syncthreads();
        {
            const int l = lb * 64 + pos; const float tt = (float)l * invLm1;
            const float w0 = 6.283185307179586f / (float)L;
            if (jg == 0) ft[pos * 33] = tt;
#pragma unroll 1
            for (int bb = 0; bb < 2; ++bb) { const int b = jg * 2 + bb; const float band = 1e-4f + (float)b * ((15.0f - 1e-4f) / 15.0f); const float ang = (w0 * (float)l) * band; ft[pos * 33 + 1 + b] = cosf(ang); ft[pos * 33 + 17 + b] = -sinf(ang); }
        }
        __syncthreads();
        {
#pragma unroll 1
            for (int ju = 0; ju < 8; ++ju) { const int j = jg * 8 + ju; float a = b1[j];
#pragma unroll 11
                for (int i = 0; i < 33; ++i) a += ft[pos * 33 + i] * w1[i * 64 + j];
                h1[pos * 65 + j] = sinf(fr[j] * a); }
        }
        __syncthreads();
        {
#pragma unroll 1
            for (int ju = 0; ju < 8; ++ju) { const int j = jg * 8 + ju; float a = b2[j];
#pragma unroll 16
                for (int i = 0; i < 64; ++i) a += h1[pos * 65 + i] * w2[i * 64 + j];
                h2[pos * 65 + j] = sinf(fr[j] * a); }
        }
        __syncthreads();
        {
            const int col = t + 512 * ci, c = col & 511;
            float wv[64];
#pragma unroll
            for (int k = 0; k < 64; ++k) wv[k] = w3[(size_t)k * 2048 + col];
            const float a0 = -4.605170185988091f / 1.5f, a1 = -4.605170185988091f / 0.3f;
            const float delta = fabsf(a0 + (float)c * ((a1 - a0) / 511.0f));
            float asum = 0.f;
#pragma unroll 1
            for (int q = 0; q < 64; ++q) {
                float a = 0.f;
#pragma unroll
                for (int k = 0; k < 64; ++k) a += h2[q * 65 + k] * wv[k];
                const int lp = lb * 64 + q; const float tp = (float)lp * invLm1;
                const float val = a * expf(-tp * delta);
                raw[(size_t)lp * 2048 + col] = val;
                if (!(lp == 0 && col >= 1024)) asum += fabsf(val);
            }
            ((float*)(p.ws + EV_FSUM))[it * 2048 + col] = asum;
        }
    }
}
__device__ __forceinline__ void ph_filt_norm(const Params& p, ldsp lds) {
    LAS float* tile = (LAS float*)lds; LAS float* inv = tile + 64 * 65;
    const int t = tid_opaque(), cc = t & 63, lg = t >> 6;
    const float* fsum = (const float*)(p.ws + EV_FSUM);
    for (int it = blockIdx.x; it < 544; it += gridDim.x) {
        const bool isc = it >= 512; int o, cb, dir, lc, L;
        if (isc) { const int i2 = it - 512; o = i2 >> 4; cb = (i2 >> 1) & 7; dir = i2 & 1; lc = 0; L = 256; }
        else { o = it >> 8; cb = (it >> 5) & 7; dir = (it >> 4) & 1; lc = it & 15; L = 4096; }
        const int c0 = cb * 64;
        const float* raw = (const float*)(p.ws + (isc ? EV_RAWC : EV_RAWL)); u16* kern = (u16*)(p.ws + (isc ? WS_KERNC : WS_KERNL)); const int RLD = 2 * L + 8;
        if (lc == (isc ? 0 : 15) && t < 64) { u16* im = kern + (size_t)(o * 512 + c0 + t) * 2 * RLD; unsigned zz; asm volatile("v_mov_b32 %0, 0" : "=v"(zz)); const u16 z16 = (u16)zz;
            if (dir == 0) im[0] = z16; else {
#pragma unroll 1
                for (int y = 2 * L - 1; y < RLD; ++y) { if (y >= 2 * L) im[y] = z16; im[RLD + y] = z16; } } }
        __syncthreads();
        if (t < 64) { float sm = 0.f; const int nlb = isc ? 4 : 64, lb0 = isc ? 0 : 4;
            for (int q = 0; q < nlb; ++q) sm += fsum[(lb0 + q) * 2048 + o * 512 + c0 + t] + fsum[(lb0 + q) * 2048 + 1024 + o * 512 + c0 + t];
            inv[t] = 1.0f / sm; }
        __syncthreads();
        for (int l0 = lc * 256; l0 < lc * 256 + 256; l0 += 64) {
#pragma unroll
            for (int i = 0; i < 8; ++i) { const int ll = lg * 8 + i; float v = raw[(size_t)(l0 + ll) * 2048 + dir * 1024 + o * 512 + c0 + cc] * inv[cc]; if (dir == 1 && l0 + ll == 0) v = 0.f; tile[ll * 65 + cc] = v; }
            __syncthreads();
            { const int cw_ = t >> 3, ls = (t & 7) * 8; u16* im = kern + (size_t)(o * 512 + c0 + cw_) * 2 * RLD;
#pragma unroll
              for (int j = 0; j < 8; ++j) { const int l = l0 + ls + j; const u16 hv = f2bf(tile[(ls + j) * 65 + cw_]);
                  if (dir == 0) { im[L - l] = hv; im[RLD + L - l - 1] = hv; }
                  else if (l > 0) { im[L + l] = hv; im[RLD + L + l - 1] = hv; } } }
            __syncthreads();
        }
    }
}

__device__ __forceinline__ void ph_norm(const Params& p, int l, int which, bool grouped, int g, bool colmajor, u16* hdst, int bstart = 0, int bcount = 0, bool dglobal = false) {
    const int t = tid_opaque(), wid = __builtin_amdgcn_readfirstlane(t >> 6), lane = t & 63;
    const float* gam = p.in[which ? I_N2G : I_N1G] + l * 1024; const float* mod = (const float*)(p.ws + WS_MOD);
    const int nrows = grouped ? MG : NTOK;
    if (bcount == 0) bcount = (int)gridDim.x;
    if ((int)blockIdx.x < bstart) return;
    for (int r = ((int)blockIdx.x - bstart) * 8 + wid; r < nrows; r += bcount * 8) {
        int grow, cond, drow;
        if (grouped) { grow = grow_of(g, r); cond = cond_of(g, r); drow = dglobal ? grow : perm_row(r, colmajor); } else { grow = r; cond = cond_of_global(r); drow = r; }
        const float* xp = (l == 0 && which == 0) ? (grow < NCTX ? p.in[I_XP] + (size_t)grow * 1024 : p.in[I_XS] + (size_t)(grow - NCTX) * 1024) : p.out + (size_t)grow * 1024;
        const float* sh = mod + ((size_t)(l * 9 + cond) * 6 + (which ? 3 : 0)) * 1024; const float* sc = sh + 1024;
        f32x4 xv[4]; float ss = 0.f;
#pragma unroll
        for (int i = 0; i < 4; ++i) { xv[i] = *(const f32x4*)(xp + i * 256 + lane * 4); ss += xv[i][0] * xv[i][0] + xv[i][1] * xv[i][1] + xv[i][2] * xv[i][2] + xv[i][3] * xv[i][3]; }
#pragma unroll
        for (int o = 32; o > 0; o >>= 1) ss += __shfl_xor(ss, o);
        const float rstd = rsqrtf(ss * (1.0f / 1024.0f) + EPS);
#pragma unroll
        for (int i = 0; i < 4; ++i) { const int c = i * 256 + lane * 4; const f32x4 gv = *(const f32x4*)(gam + c), sv = *(const f32x4*)(sc + c), hv = *(const f32x4*)(sh + c);
            f32x4 y = xv[i] * rstd * gv * (sv + 1.0f) + hv; u32x2 w; w.x = pk2(y[0], y[1]); w.y = pk2(y[2], y[3]);
            *(u32x2*)(hdst + (size_t)drow * 1024 + c) = w; }
    }
}
__device__ __forceinline__ void ph_final(const Params& p) {
    const int t = tid_opaque(), wid = __builtin_amdgcn_readfirstlane(t >> 6), lane = t & 63; const float* gam = p.in[I_FG];
    for (int r = blockIdx.x * 8 + wid; r < NTOK; r += gridDim.x * 8) {
        float* xp = p.out + (size_t)r * 1024; f32x4 xv[4]; float ss = 0.f;
#pragma unroll
        for (int i = 0; i < 4; ++i) { xv[i] = *(const f32x4*)(xp + i * 256 + lane * 4); ss += xv[i][0] * xv[i][0] + xv[i][1] * xv[i][1] + xv[i][2] * xv[i][2] + xv[i][3] * xv[i][3]; }
#pragma unroll
        for (int o = 32; o > 0; o >>= 1) ss += __shfl_xor(ss, o);
        const float rstd = rsqrtf(ss * (1.0f / 1024.0f) + EPS);
#pragma unroll
        for (int i = 0; i < 4; ++i) { const int c = i * 256 + lane * 4; *(f32x4*)(xp + c) = xv[i] * rstd * *(const f32x4*)(gam + c); }
    }
}

template <int L, int NB>
__device__ __forceinline__ void hy_load_conv(LAS u16* dst, const u16* src, float w0, float w1, float w2, float bb, int t) {
    constexpr int ZLD = L + 8, NIT = NB * L / 8 / NTHREADS;
    u32x4 rv[NIT]; float pl[NIT], pn[NIT];
#pragma unroll
    for (int i = 0; i < NIT; ++i) { const int v = t + i * NTHREADS; const int sq = v / (L / 8), p8 = (v % (L / 8)) * 8; const u16* pr = src + sq * L + p8;
        rv[i] = *(const u32x4*)pr; pl[i] = p8 > 0 ? bf2f(pr[-1]) : 0.f; pn[i] = p8 < L - 8 ? bf2f(pr[8]) : 0.f; }
#pragma unroll
    for (int i = 0; i < NIT; ++i) { const int v = t + i * NTHREADS; const int sq = v / (L / 8), p8 = (v % (L / 8)) * 8;
        float pv[8]; unpack8(rv[i], pv);
        float o[8];
#pragma unroll
        for (int k = 0; k < 8; ++k) { const float a = k > 0 ? pv[k - 1] : pl[i], d = k < 7 ? pv[k + 1] : pn[i]; o[k] = bb + w0 * a + w1 * pv[k] + w2 * d; }
        u32x4 w; w.x = pk2(o[0], o[1]); w.y = pk2(o[2], o[3]); w.z = pk2(o[4], o[5]); w.w = pk2(o[6], o[7]);
        *(LAS u32x4*)(dst + sq * ZLD + p8) = w; }
}
template <int L, int NB, int NTW, int MTW>
__device__ __forceinline__ void hyena_item(const Params& p, ldsp lds, int e, int c, int rowbase) {
    constexpr int NT1 = L / 64, ZLD = L + 8, RLD = 2 * L + 8;
    LAS u16* Zs = (LAS u16*)lds; LAS u16* Xs = Zs + NB * ZLD; LAS u16* R0 = Xs + NB * ZLD; LAS u16* R1 = R0 + RLD;
    const int t = tid_opaque(), wid = __builtin_amdgcn_readfirstlane(t >> 6), lane = t & 63, fr = lane & 15, fq = lane >> 4;
    const int nt0 = (NTW == 2) ? 2 * wid : (wid >> 1), mt0 = (MTW == 4) ? 0 : 2 * (wid & 1);
    const u16* projT = (const u16*)(p.ws + EV_PROJT); u16* yT = (u16*)(p.ws + EV_YT);
    const float* cw = p.in[I_EVCW] + (size_t)e * 3 * 2560; const float* cbias = p.in[I_EVCB] + e * 2560;
    const u16* kern = (const u16*)(p.ws + (L == 256 ? WS_KERNC : WS_KERNL));
    __syncthreads();
    if (t < NB) { unsigned zz; asm volatile("v_mov_b32 %0, 0" : "=v"(zz)); u32x4 zv; zv.x = zz; zv.y = zz; zv.z = zz; zv.w = zz; *(LAS u32x4*)(Zs + t * ZLD + L) = zv; }
    hy_load_conv<L, NB>(Zs, projT + (size_t)c * MG + rowbase, cw[c], cw[2560 + c], cw[5120 + c], cbias[c], t);
    const LAS unsigned* rl = (const LAS unsigned*)((fr & 1) ? R1 : R0) + ((L - fr + 8 * fq - (fr & 1)) >> 1);
#pragma unroll 1
    for (int o = 0; o < 2; ++o) {
        { const int gc = (o + 1) * 512 + c; hy_load_conv<L, NB>(Xs, projT + (size_t)gc * MG + rowbase, cw[gc], cw[2560 + gc], cw[5120 + gc], cbias[gc], t); }
        { const u32x4* img = (const u32x4*)(kern + (size_t)(o * 512 + c) * 2 * RLD);
          for (int v = t; v < 2 * RLD / 8; v += NTHREADS) ((LAS u32x4*)R0)[v] = img[v]; }
        __syncthreads();
        f32x4 acc[NTW][MTW];
#pragma unroll
        for (int i = 0; i < NTW; ++i)
#pragma unroll
            for (int m = 0; m < MTW; ++m) acc[i][m] = (f32x4){0.f, 0.f, 0.f, 0.f};
        if constexpr (MTW == 4) {
            const int t1lo = (16 * nt0) / NB, t1hi = (16 * (nt0 + NTW - 1) + 15) / NB;
            const int dlo = (t1lo - (NT1 - 1)) > -(NT1 - 1) ? (t1lo - (NT1 - 1)) : -(NT1 - 1), dhi = t1hi < NT1 - 1 ? t1hi : NT1 - 1;
            bf16x8 F[10];
#pragma unroll
            for (int q = 0; q < 6; ++q) { const LAS unsigned* rp = rl - 8 * (4 * dlo - 2 + q); u32x4 v; v.x = rp[0]; v.y = rp[1]; v.z = rp[2]; v.w = rp[3]; F[q] = __builtin_bit_cast(bf16x8, v); }
#pragma unroll 1
            for (int db = dlo; db <= dhi; db += 5) {
#pragma unroll
                for (int S = 0; S < 5; ++S) {
                    const int d1 = db + S;
                    if (d1 <= dhi) {
#pragma unroll
                        for (int q = 0; q < 4; ++q) { const LAS unsigned* rp = rl - 8 * (4 * (d1 + 1) + q); u32x4 v; v.x = rp[0]; v.y = rp[1]; v.z = rp[2]; v.w = rp[3]; F[(4 * S + 6 + q) % 10] = __builtin_bit_cast(bf16x8, v); }
#pragma unroll
                        for (int i = 0; i < NTW; ++i) {
                            const int lo = (16 * (nt0 + i)) / NB - d1, hi = (16 * (nt0 + i) + 15) / NB - d1;
                            if (hi >= 0 && lo <= NT1 - 1) {
                                const int n = 16 * (nt0 + i) + fr, t1 = n / NB, b = n % NB, s1 = t1 - d1; const bool ok = (unsigned)s1 < (unsigned)NT1;
                                const LAS u16* zp = Zs + b * ZLD + (ok ? 64 * s1 + 8 * fq : L);
                                const bf16x8 b0 = *(const LAS bf16x8*)zp, b1 = *(const LAS bf16x8*)(zp + (ok ? 32 : 0));
#pragma unroll
                                for (int m = 0; m < MTW; ++m) { acc[i][m] = MFMA(F[(4 * S + m + 2) % 10], b0, acc[i][m]); acc[i][m] = MFMA(F[(4 * S + m) % 10], b1, acc[i][m]); }
                            }
                        }
                    }
                }
            }
        } else {
#pragma unroll 1
        for (int d1 = -(NT1 - 1); d1 <= NT1 - 1; ++d1) {
            bool valid[NTW]; bool any = false;
#pragma unroll
            for (int i = 0; i < NTW; ++i) { const int lo = (16 * (nt0 + i)) / NB - d1, hi = (16 * (nt0 + i) + 15) / NB - d1; valid[i] = hi >= 0 && lo <= NT1 - 1; any = any || valid[i]; }
            if (!any) continue;
            bf16x8 af[MTW + 2];
#pragma unroll
            for (int q = 0; q < MTW + 2; ++q) { const int delta = mt0 - 2 + q; const LAS unsigned* rp = rl - (32 * d1 + 8 * delta);
                u32x4 v; v.x = rp[0]; v.y = rp[1]; v.z = rp[2]; v.w = rp[3]; af[q] = __builtin_bit_cast(bf16x8, v); }
#pragma unroll
            for (int i = 0; i < NTW; ++i) {
                if (!valid[i]) continue;
                const int n = 16 * (nt0 + i) + fr, t1 = n / NB, b = n % NB, s1 = t1 - d1; const bool ok = (unsigned)s1 < (unsigned)NT1;
                const LAS u16* zp = Zs + b * ZLD + 64 * (ok ? s1 : 0) + 8 * fq;
#pragma unroll
                for (int kt = 0; kt < 2; ++kt) {
                    bf16x8 bf = *(const LAS bf16x8*)(zp + 32 * kt);
                    if (!ok) bf = (bf16x8){0, 0, 0, 0, 0, 0, 0, 0};
#pragma unroll
                    for (int m = 0; m < MTW; ++m) acc[i][m] = MFMA(af[m + 2 - 2 * kt], bf, acc[i][m]);
                }
            }
        }
        }
        __syncthreads();
        { const float hb = p.in[I_HBIAS][(e * 2 + o) * 512 + c];
#pragma unroll
          for (int i = 0; i < NTW; ++i) { const int n = 16 * (nt0 + i) + fr, t1 = n / NB, b = n % NB;
#pragma unroll
              for (int m = 0; m < MTW; ++m) { const int tt = 64 * t1 + 16 * (mt0 + m) + 4 * fq;
                  const u32x2 zo = *(const LAS u32x2*)(Zs + b * ZLD + tt), xo = *(const LAS u32x2*)(Xs + b * ZLD + tt);
                  const float z0 = __uint_as_float(zo.x << 16), z1 = __uint_as_float(zo.x & 0xffff0000u), z2 = __uint_as_float(zo.y << 16), z3 = __uint_as_float(zo.y & 0xffff0000u);
                  const float x0 = __uint_as_float(xo.x << 16), x1 = __uint_as_float(xo.x & 0xffff0000u), x2 = __uint_as_float(xo.y << 16), x3 = __uint_as_float(xo.y & 0xffff0000u);
                  const float r0 = x0 * (acc[i][m][0] + z0 * hb), r1 = x1 * (acc[i][m][1] + z1 * hb), r2 = x2 * (acc[i][m][2] + z2 * hb), r3 = x3 * (acc[i][m][3] + z3 * hb);
                  if (o == 0) { u32x2 w; w.x = pk2(r0, r1); w.y = pk2(r2, r3); *(LAS u32x2*)(Zs + b * ZLD + tt) = w; }
                  else { u32x2 w; w.x = pk2(r0, r1); w.y = pk2(r2, r3); *(u32x2*)(yT + (size_t)c * MG + rowbase + b * L + tt) = w; } } } }
        __syncthreads();
    }
}
__device__ __forceinline__ void ph_hytrans(const Params& p, ldsp lds, int g) {
    LAS u16* tile = (LAS u16*)lds;
    const int t = tid_opaque();
    const u16* yT = (const u16*)(p.ws + EV_YT); u16* yg = (u16*)(p.ws + EV_Y) + (size_t)g * MG * 1024;
    for (int it = blockIdx.x; it < 2560; it += gridDim.x) {
        const int r0 = (it >> 3) * 64, c0 = (it & 7) * 64;
        __syncthreads();
        { const int c = t >> 3, r8 = (t & 7) * 8; *(LAS u32x4*)(tile + c * 72 + r8) = *(const u32x4*)(yT + (size_t)(c0 + c) * MG + r0 + r8); }
        __syncthreads();
        { const int r = t >> 3, c8 = (t & 7) * 8; u32x4 w;
          w.x = (unsigned)tile[(c8 + 0) * 72 + r] | ((unsigned)tile[(c8 + 1) * 72 + r] << 16); w.y = (unsigned)tile[(c8 + 2) * 72 + r] | ((unsigned)tile[(c8 + 3) * 72 + r] << 16);
          w.z = (unsigned)tile[(c8 + 4) * 72 + r] | ((unsigned)tile[(c8 + 5) * 72 + r] << 16); w.w = (unsigned)tile[(c8 + 6) * 72 + r] | ((unsigned)tile[(c8 + 7) * 72 + r] << 16);
          *(u32x4*)(yg + (size_t)(r0 + r) * 1024 + c0 + c8) = w; }
    }
}
__device__ __forceinline__ void ph_hyena(const Params& p, ldsp lds, int e) {
    for (int it = blockIdx.x; it < 1024; it += gridDim.x) {
        if (it < 512) hyena_item<4096, 4, 2, 4>(p, lds, e, it, CTXG); else hyena_item<256, 16, 1, 2>(p, lds, e, it - 512, 0);
    }
}

typedef short s16x4 __attribute__((ext_vector_type(4)));
__device__ __forceinline__ bf16x8 ld_tr(const LAS u16* base, int ld, int rowA, int rowB, int col0, int lane) {
    const int q = (lane & 15) >> 2, pp = lane & 3;
    const s16x4 v0 = __builtin_amdgcn_ds_read_tr16_b64_v4i16((LAS s16x4*)(base + (rowA + q) * ld + col0 + 4 * pp));
    const s16x4 v1 = __builtin_amdgcn_ds_read_tr16_b64_v4i16((LAS s16x4*)(base + (rowB + q) * ld + col0 + 4 * pp));
    return (bf16x8){v0[0], v0[1], v0[2], v0[3], v1[0], v1[1], v1[2], v1[3]};
}
__device__ __forceinline__ float wave_cumsum(float v, int lane) {
#pragma unroll
    for (int o = 1; o < 64; o <<= 1) { const float u = __shfl_up(v, o); if (lane >= o) v += u; } return v; }
__device__ __forceinline__ float wave_cummax(float v, int lane) {
#pragma unroll
    for (int o = 1; o < 64; o <<= 1) { const float u = __shfl_up(v, o); if (lane >= o) v = fmaxf(v, u); } return v; }
__device__ __forceinline__ float wave_max(float v) {
#pragma unroll
    for (int o = 32; o > 0; o >>= 1) v = fmaxf(v, __shfl_xor(v, o)); return v; }

__device__ __forceinline__ void ph_mlact(const Params& p, int e) {
    const u16* projR = (const u16*)(p.ws + EV_PROJR); u16* qk = (u16*)(p.ws + EV_H);
    const float* cw = p.in[I_EVCW] + (size_t)e * 3 * 2560 + 1536; const float* cbias = p.in[I_EVCB] + e * 2560 + 1536;
    const int t = tid_opaque(), c8 = (t & 127) * 8, rg = t >> 7;
    float w0[8], w1[8], w2[8], bb[8]; ld8f(cw + c8, w0); ld8f(cw + 2560 + c8, w1); ld8f(cw + 5120 + c8, w2); ld8f(cbias + c8, bb);
    const float scl = c8 >= 512 ? 0.08838834764831845f : 1.0f;
    for (int r0 = (blockIdx.x * 4 + rg) * 8; r0 < MG; r0 += gridDim.x * 32) {
        const int pos0 = r0 < CTXG ? (r0 & 255) : ((r0 - CTXG) & 4095), L = r0 < CTXG ? 256 : 4096;
        u32x4 rr[10];
#pragma unroll
        for (int i = 0; i < 10; ++i) { const bool ok = (i > 0 || pos0 > 0) && (i < 9 || pos0 + 8 < L); rr[i] = ok ? *(const u32x4*)(projR + (size_t)(r0 - 1 + i) * EVR + c8) : (u32x4){0u, 0u, 0u, 0u}; }
#pragma unroll
        for (int i = 0; i < 8; ++i) { float pm[8], p0[8], pp[8]; unpack8(rr[i], pm); unpack8(rr[i + 1], p0); unpack8(rr[i + 2], pp);
            float o8[8];
#pragma unroll
            for (int j = 0; j < 8; ++j) o8[j] = siluf(bb[j] + w0[j] * pm[j] + w1[j] * p0[j] + w2[j] * pp[j]) * scl;
            u32x4 w; w.x = pk2(o8[0], o8[1]); w.y = pk2(o8[2], o8[3]); w.z = pk2(o8[4], o8[5]); w.w = pk2(o8[6], o8[7]);
            *(u32x4*)(qk + (size_t)(r0 + i) * 1024 + c8) = w; }
    }
}
__device__ __forceinline__ void ph_mlA(const Params& p, ldsp lds, int e) {
    LAS u16* Ks = (LAS u16*)lds; LAS u16* Vs = Ks + 64 * 144; LAS float* wS = (LAS float*)(Vs + 64 * 144);
    const int t = tid_opaque(), wid = __builtin_amdgcn_readfirstlane(t >> 6), lane = t & 63, fr = lane & 15, fq = lane >> 4;
    const u16* projR = (const u16*)(p.ws + EV_PROJR); const u16* qk = (const u16*)(p.ws + EV_H);
    u16* CT = (u16*)(p.ws + EV_ST); float* nst = (float*)(p.ws + WS_NST); float* sc = (float*)(p.ws + WS_SC);
    const float* gb = p.in[I_MGB] + e * 16;
    for (int it = blockIdx.x; it < 2560; it += gridDim.x) {
        int chi, j, L, seqrow0, sig;
        if (it < 512) { chi = it >> 2; j = it & 3; L = 256; sig = chi >> 3; seqrow0 = sig * 256; }
        else { const int i2 = it - 512; chi = i2 >> 6; j = i2 & 63; L = 4096; sig = chi >> 3; seqrow0 = CTXG + sig * 4096; }
        const int head = (chi >> 1) & 3, dir = chi & 1;
        u32x4 rk[2], rv[2];
#pragma unroll
        for (int q = 0; q < 2; ++q) { const int v = t + q * 512, l = v >> 4, dg = (v & 15) * 8; const int pos = dir ? L - 1 - (64 * j + l) : 64 * j + l;
            rk[q] = *(const u32x4*)(qk + (size_t)(seqrow0 + pos) * 1024 + 512 + head * 128 + dg); rv[q] = *(const u32x4*)(projR + (size_t)(seqrow0 + pos) * EVR + 1024 + head * 128 + dg); }
        u16 gri, grf;
        { const int pos = dir ? L - 1 - (64 * j + lane) : 64 * j + lane; const u16* pr = projR + (size_t)(seqrow0 + pos) * EVR + (3584 - 1536); gri = pr[(dir * 2 + 0) * 4 + head]; grf = pr[(dir * 2 + 1) * 4 + head]; }
        __syncthreads();
        if (wid == 0) {
            const float gi = bf2f(gri) + gb[(dir * 2 + 0) * 4 + head];
            const float lf = logsigf(bf2f(grf) + gb[(dir * 2 + 1) * 4 + head]);
            const float b = wave_cumsum(lf, lane); const float b63 = __shfl(b, 63); const float uu = gi - b; const float gmax = wave_max(uu);
            wS[lane] = __expf(uu - gmax);
            if (lane == 0) { sc[it * 4 + 0] = b63; sc[it * 4 + 1] = b63 + gmax; }
        }
        __syncthreads();
#pragma unroll
        for (int q = 0; q < 2; ++q) { const int v = t + q * 512, l = v >> 4, dg = (v & 15) * 8;
            float kv[8]; unpack8(rk[q], kv); const float wl = wS[l];
            u32x4 w; w.x = pk2(kv[0] * wl, kv[1] * wl); w.y = pk2(kv[2] * wl, kv[3] * wl); w.z = pk2(kv[4] * wl, kv[5] * wl); w.w = pk2(kv[6] * wl, kv[7] * wl);
            *(LAS u32x4*)(Ks + l * 144 + dg) = w; *(LAS u32x4*)(Vs + l * 144 + dg) = rv[q]; }
        __syncthreads();
        {
            f32x4 acc[8];
#pragma unroll
            for (int n = 0; n < 8; ++n) acc[n] = (f32x4){0.f, 0.f, 0.f, 0.f};
#pragma unroll
            for (int kt = 0; kt < 2; ++kt) { const bf16x8 a = ld_tr(Ks, 144, 32 * kt + 8 * fq, 32 * kt + 8 * fq + 4, 16 * wid, lane);
#pragma unroll
                for (int n = 0; n < 8; ++n) acc[n] = MFMA(a, ld_tr(Vs, 144, 32 * kt + 8 * fq, 32 * kt + 8 * fq + 4, 16 * n, lane), acc[n]); }
            u16* cp = CT + (size_t)it * 16384;
#pragma unroll
            for (int n = 0; n < 8; ++n) { u32x2 w; w.x = pk2(acc[n][0], acc[n][1]); w.y = pk2(acc[n][2], acc[n][3]); *(u32x2*)(cp + (16 * n + fr) * 128 + 16 * wid + 4 * fq) = w; }
        }
        if (t < 128) { float sm = 0.f; for (int l = 0; l < 64; ++l) sm += bf2f(Ks[l * 144 + t]); nst[it * 128 + t] = sm; }
    }
}
template <int NC, bool ISCTX>
__device__ __forceinline__ void mlB_part(const Params& p, int e, int g) {
    unsigned* CT = (unsigned*)(p.ws + EV_ST); float* nst = (float*)(p.ws + WS_NST); const float* sc = (const float*)(p.ws + WS_SC); float* msc = (float*)(p.ws + WS_MSC);
    const int nch = ISCTX ? 128 : 32, total = nch * 8320;
    for (int idx = blockIdx.x * NTHREADS + tid_opaque(); idx < total; idx += gridDim.x * NTHREADS) {
        const int chi = idx / 8320, el = idx % 8320; const int sig = chi >> 3, head = (chi >> 1) & 3, dir = chi & 1;
        const int itembase = ISCTX ? chi * 4 : 512 + chi * 64;
        const bool isn = el >= 8192; const int ee = el >> 6, d = (el & 63) * 2;
        float C0 = 0.f, C1 = 0.f, m = 0.f, mrec = 0.f;
        if (!ISCTX) { const int b = g * 4 + sig; const size_t sb = (size_t)((b * 2 + e) * 2 + dir) * 4 + head;
            m = p.in[I_SM][sb];
            if (isn) C0 = p.in[I_SN][sb * 128 + (el - 8192)]; else { C0 = p.in[I_SC][(sb * 128 + d) * 128 + ee]; C1 = p.in[I_SC][(sb * 128 + d + 1) * 128 + ee]; } }
        constexpr int JB = NC < 16 ? NC : 16;
#pragma unroll 1
        for (int j0 = 0; j0 < NC; j0 += JB) {
            unsigned Lu[JB]; float Lf[JB];
#pragma unroll
            for (int j = 0; j < JB; ++j) { if (isn) Lf[j] = nst[(itembase + j0 + j) * 128 + (el - 8192)]; else Lu[j] = CT[(size_t)(itembase + j0 + j) * 8192 + el]; }
#pragma unroll
            for (int j = 0; j < JB; ++j) {
                const float a = sc[(itembase + j0 + j) * 4 + 0], gl = sc[(itembase + j0 + j) * 4 + 1];
                if (el == j0 + j) mrec = m;
                const float mn = fmaxf(a + m, gl); const float fa = __expf(a + m - mn), fb = __expf(gl - mn);
                if (isn) { const float t0 = Lf[j]; Lf[j] = C0; C0 = fa * C0 + fb * t0; }
                else { const float t0 = __uint_as_float(Lu[j] << 16), t1 = __uint_as_float(Lu[j] & 0xffff0000u); Lu[j] = pk2(C0, C1); C0 = fa * C0 + fb * t0; C1 = fa * C1 + fb * t1; }
                m = mn;
            }
#pragma unroll
            for (int j = 0; j < JB; ++j) { if (isn) nst[(itembase + j0 + j) * 128 + (el - 8192)] = Lf[j]; else CT[(size_t)(itembase + j0 + j) * 8192 + el] = Lu[j]; }
        }
        if (el < NC) msc[itembase + el] = mrec;
        if (ISCTX) { const int b = g * 16 + sig; const size_t sb = (size_t)((b * 2 + e) * 2 + dir) * 4 + head;
            if (isn) p.out[OUT_N + sb * 128 + (el - 8192)] = C0; else { p.out[OUT_C + (sb * 128 + d) * 128 + ee] = C0; p.out[OUT_C + (sb * 128 + d + 1) * 128 + ee] = C1; }
            if (el == 0) p.out[OUT_M + sb] = m; }
    }
}
__device__ __forceinline__ void ph_mlB(const Params& p, int e, int g) { mlB_part<64, false>(p, e, g); mlB_part<4, true>(p, e, g); }
__device__ __forceinline__ void ph_mlC(const Params& p, ldsp lds, int e, int g) {
    LAS u16* qs = (LAS u16*)lds; LAS u16* ks = qs + 64 * 136; LAS u16* Vs = ks + 64 * 136; LAS u16* CTs = Vs + 64 * 144; LAS u16* Sb = CTs + 144 * 136;
    LAS float* hbuf = (LAS float*)(Sb + 64 * 72); LAS float* rt = hbuf + 64 * 128; LAS float* uu = rt + 64; LAS float* ain = uu + 64; LAS float* emt = ain + 64; LAS float* den = emt + 64;
    const int t = tid_opaque(), wid = __builtin_amdgcn_readfirstlane(t >> 6), lane = t & 63, fr = lane & 15, fq = lane >> 4;
    const u16* projR = (const u16*)(p.ws + EV_PROJR); const u16* qk = (const u16*)(p.ws + EV_H);
    const u16* CT = (const u16*)(p.ws + EV_ST); const float* nst = (const float*)(p.ws + WS_NST); const float* msc = (const float*)(p.ws + WS_MSC);
    u16* yg = (u16*)(p.ws + EV_Y) + (size_t)g * MG * 1024;
    const float* gb = p.in[I_MGB] + e * 16;
    for (int it = blockIdx.x; it < 1280; it += gridDim.x) {
        int sig, head, jo, L, NC, seqrow0, cbase; bool isctx = it >= 1024;
        if (isctx) { const int i2 = it - 1024; sig = i2 >> 4; head = (i2 >> 2) & 3; jo = i2 & 3; L = 256; NC = 4; seqrow0 = sig * 256; }
        else { sig = it >> 8; head = (it >> 6) & 3; jo = it & 63; L = 4096; NC = 64; seqrow0 = CTXG + sig * 4096; }
        cbase = (sig * 4 + head) * 2;
#pragma unroll 1
        for (int dir = 0; dir < 2; ++dir) {
            const int jd = dir ? NC - 1 - jo : jo; const int chi = cbase + dir; const int item = (isctx ? chi * 4 : 512 + chi * 64) + jd;
            const float mst = msc[item];
            u32x4 rq[2], rk[2], rv[2], rc[4];
#pragma unroll
            for (int q = 0; q < 2; ++q) { const int v = t + q * 512, l = v >> 4, dg = (v & 15) * 8; const int pos = dir ? L - 1 - (64 * jd + l) : 64 * jd + l;
                const u16* qp = qk + (size_t)(seqrow0 + pos) * 1024 + head * 128 + dg; rq[q] = *(const u32x4*)qp; rk[q] = *(const u32x4*)(qp + 512);
                rv[q] = *(const u32x4*)(projR + (size_t)(seqrow0 + pos) * EVR + 1024 + head * 128 + dg); }
#pragma unroll
            for (int q = 0; q < 4; ++q) { const int v = t + q * 512; rc[q] = *(const u32x4*)(CT + (size_t)item * 16384 + v * 8); }
            u16 gri, grf;
            { const int pos = dir ? L - 1 - (64 * jd + lane) : 64 * jd + lane; const u16* pr = projR + (size_t)(seqrow0 + pos) * EVR + (3584 - 1536); gri = pr[(dir * 2 + 0) * 4 + head]; grf = pr[(dir * 2 + 1) * 4 + head]; }
            const float nval = nst[item * 128 + (t & 127)];
            __syncthreads();
            if (wid == 0) {
                const float gi = bf2f(gri) + gb[(dir * 2 + 0) * 4 + head];
                const float lf = logsigf(bf2f(grf) + gb[(dir * 2 + 1) * 4 + head]);
                const float b = wave_cumsum(lf, lane); const float u_ = gi - b; const float pm = wave_cummax(u_, lane); const float mt = b + fmaxf(mst, pm);
                rt[lane] = b - mt; uu[lane] = u_; ain[lane] = __expf(b + mst - mt); emt[lane] = __expf(-mt);
            }
#pragma unroll
            for (int q = 0; q < 2; ++q) { const int v = t + q * 512, l = v >> 4, dg = (v & 15) * 8;
                *(LAS u32x4*)(qs + l * 136 + dg) = rq[q]; *(LAS u32x4*)(ks + l * 136 + dg) = rk[q]; *(LAS u32x4*)(Vs + l * 144 + dg) = rv[q]; }
            if (t < 128) { const int l = t >> 1, hf = t & 1; u32x4 w; w.x = hf ? 0u : 0x3F80u; w.y = 0u; w.z = 0u; w.w = 0u; *(LAS u32x4*)(Vs + l * 144 + 128 + hf * 8) = w; }
#pragma unroll
            for (int q = 0; q < 4; ++q) { const int v = t + q * 512, ee = v >> 4, dg = (v & 15) * 8; *(LAS u32x4*)(CTs + ee * 136 + dg) = rc[q]; }
            for (int idx = t; idx < 16 * 128; idx += NTHREADS) { const int r = idx >> 7, d = idx & 127; CTs[(128 + r) * 136 + d] = r == 0 ? f2bf(nval) : (u16)0; }
            __syncthreads();
            {
                const int mt_ = wid >> 1;
                f32x4 a2[2] = {(f32x4){0.f, 0.f, 0.f, 0.f}, (f32x4){0.f, 0.f, 0.f, 0.f}};
#pragma unroll
                for (int kt = 0; kt < 4; ++kt) { const bf16x8 a = ldfrag(qs, (16 * mt_ + fr) * 136 + kt * 32 + fq * 8);
#pragma unroll
                    for (int i = 0; i < 2; ++i) { const int nt = (wid & 1) * 2 + i; const bf16x8 b = ldfrag(ks, (16 * nt + fr) * 136 + kt * 32 + fq * 8); a2[i] = MFMA(a, b, a2[i]); } }
#pragma unroll
                for (int i = 0; i < 2; ++i) { const int s_ = 16 * ((wid & 1) * 2 + i) + fr; const float us = uu[s_];
#pragma unroll
                    for (int jj = 0; jj < 4; ++jj) { const int l = 16 * mt_ + 4 * fq + jj; const float w = s_ <= l ? __expf(rt[l] + us) : 0.f; Sb[l * 72 + s_] = f2bf(a2[i][jj] * w); } }
            }
            __syncthreads();
            f32x4 a1[4], a2[4], d1 = (f32x4){0.f, 0.f, 0.f, 0.f}, d2 = d1;
            { const bf16x8 v0 = ld_tr(Vs, 144, 8 * fq, 8 * fq + 4, 16 * wid, lane), v1 = ld_tr(Vs, 144, 32 + 8 * fq, 32 + 8 * fq + 4, 16 * wid, lane);
#pragma unroll
              for (int mt_ = 0; mt_ < 4; ++mt_) { a1[mt_] = (f32x4){0.f, 0.f, 0.f, 0.f}; a2[mt_] = a1[mt_];
                a1[mt_] = MFMA(ldfrag(Sb, (16 * mt_ + fr) * 72 + fq * 8), v0, a1[mt_]); a1[mt_] = MFMA(ldfrag(Sb, (16 * mt_ + fr) * 72 + 32 + fq * 8), v1, a1[mt_]);
#pragma unroll
                for (int kt = 0; kt < 4; ++kt) a2[mt_] = MFMA(ldfrag(qs, (16 * mt_ + fr) * 136 + kt * 32 + fq * 8), ldfrag(CTs, (16 * wid + fr) * 136 + kt * 32 + fq * 8), a2[mt_]); } }
            {
                const int mtw = wid & 3;
                const bf16x8 v0 = ld_tr(Vs, 144, 8 * fq, 8 * fq + 4, 128, lane), v1 = ld_tr(Vs, 144, 32 + 8 * fq, 32 + 8 * fq + 4, 128, lane);
                d1 = MFMA(ldfrag(Sb, (16 * mtw + fr) * 72 + fq * 8), v0, d1); d1 = MFMA(ldfrag(Sb, (16 * mtw + fr) * 72 + 32 + fq * 8), v1, d1);
#pragma unroll
                for (int kt = 0; kt < 4; ++kt) d2 = MFMA(ldfrag(qs, (16 * mtw + fr) * 136 + kt * 32 + fq * 8), ldfrag(CTs, (128 + fr) * 136 + kt * 32 + fq * 8), d2);
                if (wid < 4 && fr == 0) {
#pragma unroll
                    for (int jj = 0; jj < 4; ++jj) { const int l = 16 * mtw + 4 * fq + jj; den[l] = d1[jj] + ain[l] * d2[jj]; } }
            }
            __syncthreads();
#pragma unroll
            for (int mt_ = 0; mt_ < 4; ++mt_)
#pragma unroll
                for (int jj = 0; jj < 4; ++jj) { const int l = 16 * mt_ + 4 * fq + jj, ee = 16 * wid + fr;
                    const float h = (a1[mt_][jj] + ain[l] * a2[mt_][jj]) * __builtin_amdgcn_rcpf(fmaxf(fabsf(den[l]), emt[l]));
                    if (dir == 0) hbuf[l * 128 + ee] = h; else hbuf[(63 - l) * 128 + ee] += h; }
        }
        __syncthreads();
        { const int row = t >> 3, seg = t & 7; const int grow = seqrow0 + 64 * jo + row;
          float v[16], ss = 0.f;
#pragma unroll
          for (int i = 0; i < 16; ++i) { v[i] = hbuf[row * 128 + seg * 16 + i]; ss += v[i] * v[i]; }
          ss += __shfl_xor(ss, 1); ss += __shfl_xor(ss, 2); ss += __shfl_xor(ss, 4);
          const float rstd = rsqrtf(ss * (1.0f / 128.0f) + EPS);
          const u16* op = projR + (size_t)grow * EVR + (3072 - 1536) + head * 128 + seg * 16; const float* ng = p.in[I_MNG] + e * 512 + head * 128 + seg * 16;
          float o0[8], o1[8]; ld8(op, o0); ld8(op + 8, o1);
          u32x4 w0, w1;
          w0.x = pk2(v[0] * rstd * ng[0] * sigmf(o0[0]), v[1] * rstd * ng[1] * sigmf(o0[1])); w0.y = pk2(v[2] * rstd * ng[2] * sigmf(o0[2]), v[3] * rstd * ng[3] * sigmf(o0[3]));
          w0.z = pk2(v[4] * rstd * ng[4] * sigmf(o0[4]), v[5] * rstd * ng[5] * sigmf(o0[5])); w0.w = pk2(v[6] * rstd * ng[6] * sigmf(o0[6]), v[7] * rstd * ng[7] * sigmf(o0[7]));
          w1.x = pk2(v[8] * rstd * ng[8] * sigmf(o1[0]), v[9] * rstd * ng[9] * sigmf(o1[1])); w1.y = pk2(v[10] * rstd * ng[10] * sigmf(o1[2]), v[11] * rstd * ng[11] * sigmf(o1[3]));
          w1.z = pk2(v[12] * rstd * ng[12] * sigmf(o1[4]), v[13] * rstd * ng[13] * sigmf(o1[5])); w1.w = pk2(v[14] * rstd * ng[14] * sigmf(o1[6]), v[15] * rstd * ng[15] * sigmf(o1[7]));
          u16* yp = yg + (size_t)grow * 1024 + 512 + head * 128 + seg * 16; *(u32x4*)yp = w0; *(u32x4*)(yp + 8) = w1; }
    }
}

__device__ __forceinline__ bf16x8 ld_perm(const LAS u16* rowp, int kt, int fq) {
    const u32x2 a = *(const LAS u32x2*)(rowp + 32 * kt + 4 * fq), b = *(const LAS u32x2*)(rowp + 32 * kt + 16 + 4 * fq);
    u32x4 v; v.x = a.x; v.y = a.y; v.z = b.x; v.w = b.y; return __builtin_bit_cast(bf16x8, v); }
__device__ __forceinline__ bf16x8 pack_acc(f32x4 a, f32x4 b) { u32x4 v; v.x = pk2(a[0], a[1]); v.y = pk2(a[2], a[3]); v.z = pk2(b[0], b[1]); v.w = pk2(b[2], b[3]); return __builtin_bit_cast(bf16x8, v); }
__device__ __forceinline__ void ph_ssdact(const Params& p, int o) {
    const u16* raw = (const u16*)(p.ws + OD_RAW); u16* act = (u16*)(p.ws + OD_ACT);
    const float* cw = p.in[I_ODCW] + (size_t)o * 3 * 4096; const float* cbias = p.in[I_ODCB] + o * 4096;
    const int t = tid_opaque(), c8 = (t & 511) * 8;
    float w0[8], w1[8], w2[8], bb[8]; ld8f(cw + c8, w0); ld8f(cw + 4096 + c8, w1); ld8f(cw + 8192 + c8, w2); ld8f(cbias + c8, bb);
    for (int r0 = blockIdx.x * 8; r0 < MG; r0 += gridDim.x * 8) {
        const int pos0 = r0 < CTXG ? (r0 & 255) : ((r0 - CTXG) & 4095), L = r0 < CTXG ? 256 : 4096;
        u32x4 rr[10];
#pragma unroll
        for (int i = 0; i < 10; ++i) { const bool ok = (i > 0 || pos0 > 0) && (i < 9 || pos0 + 8 < L); rr[i] = ok ? *(const u32x4*)(raw + (size_t)(r0 - 1 + i) * 4096 + c8) : (u32x4){0u, 0u, 0u, 0u}; }
#pragma unroll
        for (int i = 0; i < 8; ++i) { float pm[8], p0[8], pp[8]; unpack8(rr[i], pm); unpack8(rr[i + 1], p0); unpack8(rr[i + 2], pp);
            float o8[8];
#pragma unroll
            for (int j = 0; j < 8; ++j) o8[j] = siluf(bb[j] + w0[j] * pm[j] + w1[j] * p0[j] + w2[j] * pp[j]);
            u32x4 w; w.x = pk2(o8[0], o8[1]); w.y = pk2(o8[2], o8[3]); w.z = pk2(o8[4], o8[5]); w.w = pk2(o8[6], o8[7]);
            *(u32x4*)(act + (size_t)(r0 + i) * 4096 + c8) = w; }
    }
}
template <bool PASSB>
__device__ __forceinline__ void ssd_pass(const Params& p, ldsp lds, int o, int g) {
    LAS u16* Cm = (LAS u16*)lds; LAS u16* Bm = Cm + 64 * 144; LAS u16* X = Bm + 64 * 144; LAS u16* X2 = X + 64 * 272;
    LAS float* cbL = (LAS float*)(X2 + 64 * 272); LAS float* acsb = cbL + 64 * 68; LAS float* dtsb = acsb + 512;
    const int t = tid_opaque(), wid = __builtin_amdgcn_readfirstlane(t >> 6), lane = t & 63, fr = lane & 15, fq = lane >> 4;
    const int hh = wid >> 1, pt0 = 2 * (wid & 1);
    const u16* act = (const u16*)(p.ws + OD_ACT); const u16* zd = (const u16*)(p.ws + OD_ZD);
    float* segbuf = (float*)(p.ws + OD_SEG); float* dseg = (float*)(p.ws + OD_DSEG);
    const int nitems = PASSB ? 768 : 448;
    for (int it = blockIdx.x; it < nitems; it += gridDim.x) {
        int sig, grp, dir, seg, L, nsteps, seqrow0; bool islat = true;
        if (PASSB) {
            islat = it < 512;
            if (islat) { seg = it & 7; dir = (it >> 3) & 1; grp = (it >> 4) & 7; sig = it >> 7; L = 4096; nsteps = 8; seqrow0 = CTXG + sig * 4096; }
            else { const int i2 = it - 512; seg = 0; dir = i2 & 1; grp = (i2 >> 1) & 7; sig = i2 >> 4; L = 256; nsteps = 4; seqrow0 = sig * 256; }
        } else { seg = it % 7; const int r = it / 7; dir = r & 1; grp = (r >> 1) & 7; sig = r >> 4; L = 4096; nsteps = 8; seqrow0 = CTXG + sig * 4096; }
        const int head = grp * 4 + hh, chain = (sig * 8 + grp) * 2 + dir, jd0 = seg * 8;
        u16* ydir = (u16*)(p.ws + (dir ? OD_YB : OD_YF));
        f32x4 ST[2][8];
        {
            const float* sp = nullptr;
            if (PASSB && islat) sp = seg == 0 ? p.in[I_SSD] + ((size_t)(((g * 4 + sig) * 2 + o) * 2 + dir) * 32 + head) * 8192 : segbuf + ((size_t)(chain * 7 + seg - 1) * 4 + hh) * 8192;
#pragma unroll
            for (int pi = 0; pi < 2; ++pi)
#pragma unroll
                for (int n = 0; n < 8; ++n) ST[pi][n] = sp ? *(const f32x4*)(sp + (16 * (pt0 + pi) + fr) * 128 + 16 * n + 4 * fq) : (f32x4){0.f, 0.f, 0.f, 0.f};
        }
        float Aneg = 0.f, dtb = 0.f, dsum = 0.f;
        if (wid < 4) { const int hd = grp * 4 + wid; Aneg = -__expf(p.in[I_ALOG][(o * 2 + dir) * 32 + hd]); dtb = p.in[I_DTB][(o * 2 + dir) * 32 + hd]; }
        __syncthreads();
        float dtp_n = 0.f;
        if (wid < 4) { const int pos = dir ? L - 1 - (64 * jd0 + lane) : 64 * jd0 + lane;
            const float dt = softplusf(bf2f(zd[(size_t)(seqrow0 + pos) * ZDL + 2048 + dir * 32 + grp * 4 + wid]) + dtb); const float ac = wave_cumsum(dt * Aneg, lane);
            dtsb[wid * 64 + lane] = dt; acsb[wid * 64 + lane] = ac; dsum += __shfl(ac, 63);
            const int pos1 = dir ? L - 1 - (64 * (jd0 + 1) + lane) : 64 * (jd0 + 1) + lane; dtp_n = bf2f(zd[(size_t)(seqrow0 + pos1) * ZDL + 2048 + dir * 32 + grp * 4 + wid]); }
        __syncthreads();
        u32x4 rb[2], rx[4];
#pragma unroll
        for (int q = 0; q < 2; ++q) { const int v = t + q * 512, l = v >> 4, ng = (v & 15) * 8; const int pos = dir ? L - 1 - (64 * jd0 + l) : 64 * jd0 + l;
            const u16* rowp = act + (size_t)(seqrow0 + pos) * 4096; rb[q] = *(const u32x4*)(rowp + 2048 + grp * 128 + ng); }
#pragma unroll
        for (int q = 0; q < 4; ++q) { const int v = t + q * 512, l = v >> 5, cg_ = (v & 31) * 8; const int pos = dir ? L - 1 - (64 * jd0 + l) : 64 * jd0 + l;
            rx[q] = *(const u32x4*)(act + (size_t)(seqrow0 + pos) * 4096 + grp * 256 + cg_); }
#pragma unroll 1
        for (int st = 0; st < nsteps; ++st) {
            const int jd = jd0 + st, cur = st & 1;
            {
                u32x4 rc[2];
                if (PASSB) {
#pragma unroll
                    for (int q = 0; q < 2; ++q) { const int v = t + q * 512, l = v >> 4, ng = (v & 15) * 8; const int pos = dir ? L - 1 - (64 * jd + l) : 64 * jd + l;
                        rc[q] = *(const u32x4*)(act + (size_t)(seqrow0 + pos) * 4096 + 3072 + grp * 128 + ng); } }
#pragma unroll
                for (int q = 0; q < 2; ++q) { const int v = t + q * 512, l = v >> 4, ng = (v & 15) * 8; *(LAS u32x4*)(Bm + l * 144 + ng) = rb[q]; }
#pragma unroll
                for (int q = 0; q < 4; ++q) { const int v = t + q * 512, l = v >> 5, cg_ = (v & 31) * 8, h = cg_ >> 6;
                    float xv[8]; unpack8(rx[q], xv);
                    const float dt = dtsb[(cur * 4 + h) * 64 + l], de = __expf(acsb[(cur * 4 + h) * 64 + 63] - acsb[(cur * 4 + h) * 64 + l]);
#pragma unroll
                    for (int jj = 0; jj < 8; ++jj) xv[jj] *= dt;
                    u32x4 w;
                    if (PASSB) { w.x = pk2(xv[0], xv[1]); w.y = pk2(xv[2], xv[3]); w.z = pk2(xv[4], xv[5]); w.w = pk2(xv[6], xv[7]); *(LAS u32x4*)(X + l * 272 + cg_) = w; }
                    w.x = pk2(xv[0] * de, xv[1] * de); w.y = pk2(xv[2] * de, xv[3] * de); w.z = pk2(xv[4] * de, xv[5] * de); w.w = pk2(xv[6] * de, xv[7] * de); *(LAS u32x4*)(X2 + l * 272 + cg_) = w; }
                if (PASSB) {
#pragma unroll
                    for (int q = 0; q < 2; ++q) { const int v = t + q * 512, l = v >> 4, ng = (v & 15) * 8; *(LAS u32x4*)(Cm + l * 144 + ng) = rc[q]; } }
                if (st + 1 < nsteps) {
#pragma unroll
                    for (int q = 0; q < 2; ++q) { const int v = t + q * 512, l = v >> 4, ng = (v & 15) * 8; const int pos = dir ? L - 1 - (64 * (jd + 1) + l) : 64 * (jd + 1) + l;
                        const u16* rowp = act + (size_t)(seqrow0 + pos) * 4096; rb[q] = *(const u32x4*)(rowp + 2048 + grp * 128 + ng); }
#pragma unroll
                    for (int q = 0; q < 4; ++q) { const int v = t + q * 512, l = v >> 5, cg_ = (v & 31) * 8; const int pos = dir ? L - 1 - (64 * (jd + 1) + l) : 64 * (jd + 1) + l;
                        rx[q] = *(const u32x4*)(act + (size_t)(seqrow0 + pos) * 4096 + grp * 256 + cg_); }
                }
            }
            if (wid < 4 && st + 1 < nsteps) {
                const float dt = softplusf(dtp_n + dtb); const float ac = wave_cumsum(dt * Aneg, lane);
                dtsb[((cur ^ 1) * 4 + wid) * 64 + lane] = dt; acsb[((cur ^ 1) * 4 + wid) * 64 + lane] = ac; dsum += __shfl(ac, 63);
                if (st + 2 < nsteps) { const int pos2 = dir ? L - 1 - (64 * (jd + 2) + lane) : 64 * (jd + 2) + lane; dtp_n = bf2f(zd[(size_t)(seqrow0 + pos2) * ZDL + 2048 + dir * 32 + grp * 4 + wid]); } }
            __syncthreads();
            const LAS float* ac = acsb + (cur * 4 + hh) * 64;
            if (PASSB) {
#pragma unroll 1
                for (int rep_ = 0; rep_ < ((PROBE & 2048) ? 2 : 1); ++rep_) {
                    const int stile = wid >> 1;
                    f32x4 a2[2] = {(f32x4){0.f, 0.f, 0.f, 0.f}, (f32x4){0.f, 0.f, 0.f, 0.f}};
#pragma unroll
                    for (int kt = 0; kt < 4; ++kt) { const bf16x8 a = ldfrag(Bm, (16 * stile + fr) * 144 + kt * 32 + fq * 8);
#pragma unroll
                        for (int i = 0; i < 2; ++i) a2[i] = MFMA(a, ldfrag(Cm, (16 * (2 * (wid & 1) + i) + fr) * 144 + kt * 32 + fq * 8), a2[i]); }
#pragma unroll
                    for (int i = 0; i < 2; ++i) *(LAS f32x4*)(cbL + (16 * (2 * (wid & 1) + i) + fr) * 68 + 16 * stile + 4 * fq) = a2[i];
                }
                __syncthreads();
                auto ltbody = [&](const int lt, auto k1tag) {
                    constexpr bool K1 = decltype(k1tag)::value;
                    const int l = 16 * lt + fr; const float acl = ac[l];
                    asm volatile("" : "+v"(ST[0][0]), "+v"(ST[0][1]), "+v"(ST[0][2]), "+v"(ST[0][3]), "+v"(ST[0][4]), "+v"(ST[0][5]), "+v"(ST[0][6]), "+v"(ST[0][7]));
                    asm volatile("" : "+v"(ST[1][0]), "+v"(ST[1][1]), "+v"(ST[1][2]), "+v"(ST[1][3]), "+v"(ST[1][4]), "+v"(ST[1][5]), "+v"(ST[1][6]), "+v"(ST[1][7]));
                    bf16x8 cm[4], xa[2][2];
#pragma unroll
                    for (int kt = 0; kt < 4; ++kt) cm[kt] = ld_perm(Cm + l * 144, kt, fq);
#pragma unroll
                    for (int pi = 0; pi < 2; ++pi)
#pragma unroll
                        for (int kt = 0; kt < (K1 ? 2 : 1); ++kt) xa[pi][kt] = ld_tr(X, 272, 32 * kt + 4 * fq, 32 * kt + 16 + 4 * fq, 64 * hh + 16 * (pt0 + pi), lane);
                    bf16x8 pf[2];
#pragma unroll
                    for (int kt = 0; kt < (K1 ? 2 : 1); ++kt) { const int sA = 32 * kt + 4 * fq, sB = sA + 16;
                        const f32x4 ca = *(const LAS f32x4*)(cbL + l * 68 + sA), cb_ = *(const LAS f32x4*)(cbL + l * 68 + sB), aa = *(const LAS f32x4*)(ac + sA), ab = *(const LAS f32x4*)(ac + sB);
                        f32x4 ra, rb_;
#pragma unroll
                        for (int jj = 0; jj < 4; ++jj) { ra[jj] = (sA + jj <= l) ? ca[jj] * __expf(acl - aa[jj]) : 0.f; rb_[jj] = (sB + jj <= l) ? cb_[jj] * __expf(acl - ab[jj]) : 0.f; }
                        pf[kt] = pack_acc(ra, rb_); }
                    const float eacl = __expf(acl);
                    const int pos = dir ? L - 1 - (64 * jd + l) : 64 * jd + l;
                    f32x4 y0 = (f32x4){0.f, 0.f, 0.f, 0.f}, y1 = y0;
#pragma unroll
                    for (int kt = 0; kt < 4; ++kt) { y0 = MFMA(pack_acc(ST[0][2 * kt], ST[0][2 * kt + 1]), cm[kt], y0); y1 = MFMA(pack_acc(ST[1][2 * kt], ST[1][2 * kt + 1]), cm[kt], y1); }
                    y0 = y0 * eacl; y1 = y1 * eacl;
#pragma unroll
                    for (int kt = 0; kt < (K1 ? 2 : 1); ++kt) { y0 = MFMA(xa[0][kt], pf[kt], y0); y1 = MFMA(xa[1][kt], pf[kt], y1); }
                    { u32x2 w; w.x = pk2(y0[0], y0[1]); w.y = pk2(y0[2], y0[3]); *(u32x2*)(ydir + (size_t)(seqrow0 + pos) * 2048 + head * 64 + 16 * pt0 + 4 * fq) = w;
                      w.x = pk2(y1[0], y1[1]); w.y = pk2(y1[2], y1[3]); *(u32x2*)(ydir + (size_t)(seqrow0 + pos) * 2048 + head * 64 + 16 * (pt0 + 1) + 4 * fq) = w; }
                };
#pragma unroll 1
                for (int lt = 0; lt < 2; ++lt) ltbody(lt, std::false_type{});
#pragma unroll 1
                for (int lt = 2; lt < 4; ++lt) ltbody(lt, std::true_type{});
            }
            {
                const float dec = __expf(ac[63]);
#pragma unroll
                for (int pi = 0; pi < 2; ++pi) {
                    __builtin_amdgcn_sched_barrier(0);
                    const bf16x8 b0 = ld_tr(X2, 272, 8 * fq, 8 * fq + 4, 64 * hh + 16 * (pt0 + pi), lane), b1 = ld_tr(X2, 272, 32 + 8 * fq, 32 + 8 * fq + 4, 64 * hh + 16 * (pt0 + pi), lane);
#pragma unroll
                    for (int n = 0; n < 8; ++n) { ST[pi][n] = ST[pi][n] * dec;
                        ST[pi][n] = MFMA(ld_tr(Bm, 144, 8 * fq, 8 * fq + 4, 16 * n, lane), b0, ST[pi][n]); ST[pi][n] = MFMA(ld_tr(Bm, 144, 32 + 8 * fq, 32 + 8 * fq + 4, 16 * n, lane), b1, ST[pi][n]); }
                }
            }
            __syncthreads();
        }
        {
            float* sp = nullptr;
            if (!PASSB) { sp = segbuf + ((size_t)(chain * 7 + seg) * 4 + hh) * 8192; if (wid < 4 && lane == 0) dseg[(chain * 7 + seg) * 4 + wid] = dsum; }
            else if (!islat) sp = p.out + OUT_SSD + ((size_t)(((g * 16 + sig) * 2 + o) * 2 + dir) * 32 + head) * 8192;
            if (sp) {
#pragma unroll
                for (int pi = 0; pi < 2; ++pi)
#pragma unroll
                    for (int n = 0; n < 8; ++n) *(f32x4*)(sp + (16 * (pt0 + pi) + fr) * 128 + 16 * n + 4 * fq) = ST[pi][n];
            }
        }
    }
}
__device__ __forceinline__ void ph_ssdA(const Params& p, ldsp lds, int o, int g) { ssd_pass<false>(p, lds, o, g); }
__device__ __forceinline__ void ph_ssdB(const Params& p, ldsp lds, int o, int g) { ssd_pass<true>(p, lds, o, g); }
__device__ __forceinline__ void ph_ssdcomb(const Params& p, int o, int g) {
    float* segbuf = (float*)(p.ws + OD_SEG); const float* dseg = (const float*)(p.ws + OD_DSEG);
    for (int idx = blockIdx.x * NTHREADS + tid_opaque(); idx < 64 * 4 * 8192; idx += gridDim.x * NTHREADS) {
        const int chain = idx >> 15, h = (idx >> 13) & 3, el = idx & 8191; const int sig = chain >> 4, grp = (chain >> 1) & 7, dir = chain & 1;
        float cur = p.in[I_SSD][((size_t)(((g * 4 + sig) * 2 + o) * 2 + dir) * 32 + grp * 4 + h) * 8192 + el];
        float Lv[7], dv[7];
#pragma unroll
        for (int sg = 0; sg < 7; ++sg) { const int en = (chain * 7 + sg) * 4 + h; Lv[sg] = segbuf[(size_t)en * 8192 + el]; dv[sg] = dseg[en]; }
#pragma unroll
        for (int sg = 0; sg < 7; ++sg) { cur = __expf(dv[sg]) * cur + Lv[sg]; Lv[sg] = cur; }
#pragma unroll
        for (int sg = 0; sg < 7; ++sg) { const int en = (chain * 7 + sg) * 4 + h; segbuf[(size_t)en * 8192 + el] = Lv[sg]; }
    }
}
__device__ __forceinline__ void ph_ssdfin(const Params& p, int o) {
    const int t = tid_opaque(), wid = __builtin_amdgcn_readfirstlane(t >> 6), lane = t & 63;
    const u16* act = (const u16*)(p.ws + OD_ACT); const u16* zd = (const u16*)(p.ws + OD_ZD); u16* yf = (u16*)(p.ws + OD_YF); const u16* yb = (const u16*)(p.ws + OD_YB);
    const float* ng = p.in[I_SSDNG] + o * 2048; const float* Dh = p.in[I_SSDD] + o * 32;
    for (int r = blockIdx.x * 8 + wid; r < MG; r += gridDim.x * 8) {
        u32x4 ra[4], rb[4], rx[4], rz[4];
#pragma unroll
        for (int i = 0; i < 4; ++i) { const int c0 = i * 512 + lane * 8; ra[i] = *(const u32x4*)(yf + (size_t)r * 2048 + c0); rb[i] = *(const u32x4*)(yb + (size_t)r * 2048 + c0);
            rx[i] = *(const u32x4*)(act + (size_t)r * 4096 + c0); rz[i] = *(const u32x4*)(zd + (size_t)r * ZDL + c0); }
        float yv[4][8]; float ss = 0.f;
#pragma unroll
        for (int i = 0; i < 4; ++i) { const int c0 = i * 512 + lane * 8; float a[8], b[8], x[8], z[8]; unpack8(ra[i], a); unpack8(rb[i], b); unpack8(rx[i], x); unpack8(rz[i], z);
            const float dh = Dh[c0 >> 6];
#pragma unroll
            for (int j = 0; j < 8; ++j) { const float v = (a[j] + b[j] + dh * x[j]) * siluf(z[j]); yv[i][j] = v; ss += v * v; } }
#pragma unroll
        for (int q = 32; q > 0; q >>= 1) ss += __shfl_xor(ss, q);
        const float rstd = rsqrtf(ss * (1.0f / 2048.0f) + EPS);
#pragma unroll
        for (int i = 0; i < 4; ++i) { const int c0 = i * 512 + lane * 8; float gv[8]; ld8f(ng + c0, gv); u32x4 w;
            w.x = pk2(yv[i][0] * rstd * gv[0], yv[i][1] * rstd * gv[1]); w.y = pk2(yv[i][2] * rstd * gv[2], yv[i][3] * rstd * gv[3]);
            w.z = pk2(yv[i][4] * rstd * gv[4], yv[i][5] * rstd * gv[5]); w.w = pk2(yv[i][6] * rstd * gv[6], yv[i][7] * rstd * gv[7]);
            *(u32x4*)(yf + (size_t)r * 2048 + c0) = w; }
    }
}
#define XB_TMO      128
#define XB_XCNT(j)  (256  + 64 * (j))
#define XB_XSUB(j)  (1280 + 64 * (j))
#define XB_XGEN(j)  (2304 + 64 * (j))
#define XB_TOP      3328
#define XB_TOPGEN   3392
#define XCD_BAR_WORDS 3456
#define XB_SPIN_CAP (1u << 24)
__device__ __forceinline__ unsigned xb_ld(unsigned* p)              { return __hip_atomic_load(p, __ATOMIC_RELAXED, __HIP_MEMORY_SCOPE_AGENT); }
__device__ __forceinline__ unsigned xb_add(unsigned* p, unsigned v) { return __hip_atomic_fetch_add(p, v, __ATOMIC_RELAXED, __HIP_MEMORY_SCOPE_AGENT); }
__device__ __forceinline__ unsigned xb_xcc_id() { return (unsigned)__builtin_amdgcn_s_getreg((3 << 11) | 20) & 0xFu; }
#define XB_SPIN(cond, bar) do { unsigned _sp = 0; while (cond) { __builtin_amdgcn_s_sleep(1); \
    if ((++_sp & 255u) == 0u) { if (xb_ld(&(bar)[XB_TMO])) break; if (_sp > XB_SPIN_CAP) { atomicAdd(&(bar)[XB_TMO], 1u); break; } } } } while (0)
struct XcdBarrier { unsigned* bar; unsigned x; volatile LAS unsigned* st; };
__device__ __forceinline__ XcdBarrier xcd_barrier_post(unsigned* bar, volatile LAS unsigned* st) {
    XcdBarrier b; b.bar = bar; b.x = xb_xcc_id(); b.st = st;
    if (threadIdx.x == 0) (void)xb_add(&bar[XB_XCNT(b.x)], 1u);
    return b;
}
__device__ __forceinline__ void xcd_barrier_complete(unsigned* bar, unsigned x, unsigned& nloc, unsigned& nx) {
    const unsigned G = gridDim.x * gridDim.y * gridDim.z;
    unsigned sum, cnt, mine, sp = 0u;
    for (;;) {
        sum = 0u; cnt = 0u; mine = 0u;
#pragma unroll
        for (unsigned j = 0; j < 16; ++j) { const unsigned c = xb_ld(&bar[XB_XCNT(j)]); sum += c; cnt += (c > 0u) ? 1u : 0u; mine = (j == x) ? c : mine; }
        if (sum == G) break;
        __builtin_amdgcn_s_sleep(1);
        if ((++sp & 255u) == 0u) { if (xb_ld(&bar[XB_TMO])) break; if (sp > XB_SPIN_CAP) { atomicAdd(&bar[XB_TMO], 1u); break; } }
    }
    nloc = mine > 0u ? mine : 1u; nx = cnt > 0u ? cnt : 1u;
}
__device__ __forceinline__ void xcd_barrier(const XcdBarrier& b) {
    asm volatile("s_waitcnt vmcnt(0)" ::: "memory");
    __syncthreads();
    if (threadIdx.x == 0) {
        unsigned* bar = b.bar;
        __builtin_amdgcn_s_waitcnt(0);
        unsigned nloc = b.st[0], nx = b.st[1];
        if (nloc == 0u) { xcd_barrier_complete(bar, b.x, nloc, nx); b.st[0] = nloc; b.st[1] = nx; }
        const unsigned old = xb_add(&bar[XB_XSUB(b.x)], 1u);
        const unsigned gen = old / nloc;
        if (old + 1u == (gen + 1u) * nloc) {
            __builtin_amdgcn_fence(__ATOMIC_RELEASE, "agent");
            asm volatile("s_waitcnt vmcnt(0)" ::: "memory");
            const unsigned og = xb_add(&bar[XB_TOP], 1u);
            const unsigned tg = og / nx;
            if (og + 1u == (tg + 1u) * nx) xb_add(&bar[XB_TOPGEN], 1u);
            else XB_SPIN(xb_ld(&bar[XB_TOPGEN]) == tg, bar);
            __builtin_amdgcn_fence(__ATOMIC_ACQUIRE, "agent");
            xb_add(&bar[XB_XGEN(b.x)], 1u);
            asm volatile("s_waitcnt vmcnt(0)" ::: "memory");
        } else {
            XB_SPIN(xb_ld(&bar[XB_XGEN(b.x)]) == gen, bar);
            __builtin_amdgcn_fence(__ATOMIC_ACQUIRE, "agent");
            asm volatile("s_waitcnt vmcnt(0)" ::: "memory");
        }
    }
    __syncthreads();
}
__global__ void __launch_bounds__(NTHREADS, 2) fwd_megakernel(Params p) {
    extern __shared__ __attribute__((aligned(16))) unsigned char shm[];
    ldsp lds = (ldsp)shm;
    cg::grid_group grid = cg::this_grid();
    const float* mod = (const float*)(p.ws + WS_MOD);

    unsigned* bar_words = (unsigned*)(p.ws + WS_BAR);
    volatile LAS unsigned* bar_st = (volatile LAS unsigned*)(lds + LDS_BYTES - 16);
    if (blockIdx.x == 0) for (int i = threadIdx.x; i < XCD_BAR_WORDS; i += NTHREADS) __hip_atomic_store(bar_words + i, 0u, __ATOMIC_RELAXED, __HIP_MEMORY_SCOPE_AGENT);
    if (threadIdx.x < 2) bar_st[threadIdx.x] = 0u;
    __syncthreads();
    DUP(32, ph_modp(p, lds)); DUP(32, ph_wconv_layer(p, lds, 0)); DUP(32, ph_filt_raw(p, lds, 0));
    grid.sync();
    (void)xcd_barrier_post(bar_words, bar_st);
    ph_modfin(p);
    GSYNC();
    for (int l = 0; l < 4; ++l) {
        const int e = l >> 1; const bool even = (l & 1) == 0, colmajor = l >= 2;
        if (l > 0) { DUP(32, ph_wconv_layer(p, lds, l)); if (l == 2) DUP(32, ph_filt_raw(p, lds, 1)); GSYNC(); }
        for (int g = 0; g < NG; ++g) {
            if (even) {
                DUP(16, ph_norm(p, l, 0, true, g, colmajor, (u16*)(p.ws + EV_H))); if (g == 0) DUP(32, ph_filt_norm(p, lds));
                GSYNC();
                { EpiProjEven E; E.projT = (u16*)(p.ws + EV_PROJT); E.projR = (u16*)(p.ws + EV_PROJR); DUP(2, run_gemm(lds, (const u16*)(p.ws + EV_H), (const u16*)(p.ws + WT_IN), MG, EVPAD, 1024, E)); }
                GSYNC();
                DUP(256, ph_mlact(p, e));
                GSYNC();
                DUP(4, ph_mlA(p, lds, e)); DUP(8, ph_hyena(p, lds, e));
                GSYNC();
                ph_mlB(p, e, g); DUP(256, ph_hytrans(p, lds, g));
                GSYNC();
                DUP(4, ph_mlC(p, lds, e, g));
                GSYNC();
                if (g == NG - 1) {
                    { EpiResid E; E.x = p.out; E.mod = mod; E.l = l; E.gidx = 2; E.g = 0; E.colmajor = colmajor; E.grouped = true; E.first = (l == 0); E.xp0 = p.in[I_XP]; E.xs0 = p.in[I_XS]; run_gemm(lds, (const u16*)(p.ws + EV_Y), (const u16*)(p.ws + WT_OUT), 2 * MG, 1024, 1024, E); }
                    GSYNC();
                }
            } else {
                if (g == 0) { DUP(16, ph_norm(p, l, 0, true, g, colmajor, (u16*)(p.ws + OD_H))); GSYNC(); }
                { EpiProjOdd E; E.zd = (u16*)(p.ws + OD_ZD); E.raw = (u16*)(p.ws + OD_RAW); DUP(2, run_gemm(lds, (const u16*)(p.ws + OD_H), (const u16*)(p.ws + WT_IN), MG, ODPAD, 1024, E)); }
                GSYNC();
                DUP(256, ph_ssdact(p, e));
                GSYNC();
                DUP(1, ph_ssdA(p, lds, e, g));
                GSYNC();
                ph_ssdcomb(p, e, g);
                GSYNC();
                DUP(1, ph_ssdB(p, lds, e, g));
                GSYNC();
                ph_ssdfin(p, e);
                GSYNC();
                { EpiResid E; E.x = p.out; E.mod = mod; E.l = l; E.gidx = 2; E.g = g; E.colmajor = colmajor; E.grouped = true; E.first = (l == 0); E.xp0 = p.in[I_XP]; E.xs0 = p.in[I_XS]; run_gemm(lds, (const u16*)(p.ws + OD_YF), (const u16*)(p.ws + WT_OUT), MG, 1024, 2048, E); }
                if (g == 0) { const int nb = (int)gridDim.x, two = (MG / 256) * 4 - nb;
                    if (two > 0 && two < nb) ph_norm(p, l, 0, true, 1, colmajor, (u16*)(p.ws + OD_H), two, nb - two); else ph_norm(p, l, 0, true, 1, colmajor, (u16*)(p.ws + OD_H)); }
                else { const int nb = (int)gridDim.x, two = (MG / 256) * 4 - nb;
                    if (two > 0 && two < nb) ph_norm(p, l, 1, true, 0, false, (u16*)(p.ws + FF_H), two, nb - two, true); else ph_norm(p, l, 1, true, 0, false, (u16*)(p.ws + FF_H), 0, 0, true); }
                GSYNC();
            }
        }
        if (even) { DUP(16, ph_norm(p, l, 1, false, 0, false, (u16*)(p.ws + FF_H))); } else ph_norm(p, l, 1, true, 1, false, (u16*)(p.ws + FF_H), 0, 0, true);
        GSYNC();
        { EpiSwiGLU E; E.uo = (u16*)(p.ws + FF_U); DUP(2, run_gemm(lds, (const u16*)(p.ws + FF_H), (const u16*)(p.ws + WT_F13), NTOK, 2 * FH, 1024, E)); }
        GSYNC();
        { EpiResid E; E.x = p.out; E.mod = mod; E.l = l; E.gidx = 5; E.g = 0; E.colmajor = false; E.grouped = false; E.first = false; E.xp0 = p.in[I_XP]; E.xs0 = p.in[I_XS]; run_gemm(lds, (const u16*)(p.ws + FF_U), (const u16*)(p.ws + WT_F2), NTOK, 1024, FH, E); }
        GSYNC();
    }
    ph_final(p);
}

extern "C" void kernel_launch(void* const* d_in, const int* in_sizes, int n_in, void* d_out, int out_size, void* d_ws, size_t ws_size, hipStream_t stream) {
    static int grid_blocks = 0;
    if (!grid_blocks) {
        int dev = 0, cus = 0, per_cu = 0;
        hipGetDevice(&dev);
        hipDeviceGetAttribute(&cus, hipDeviceAttributeMultiprocessorCount, dev);
        hipFuncSetAttribute((const void*)fwd_megakernel, hipFuncAttributeMaxDynamicSharedMemorySize, LDS_BYTES);
        hipOccupancyMaxActiveBlocksPerMultiprocessor(&per_cu, (const void*)fwd_megakernel, NTHREADS, LDS_BYTES);
        if (per_cu < 1) per_cu = 1;
        grid_blocks = cus * per_cu;
        if (ws_size < 504 * MiB) fprintf(stderr, "kernel_launch: workspace too small: %zu\n", ws_size);
    }
    Params p{};
    for (int i = 0; i < 37; ++i) p.in[i] = (const float*)d_in[i];
    p.out = (float*)d_out; p.ws = (unsigned char*)d_ws;
    void* args[] = {&p};
    hipError_t er = hipLaunchCooperativeKernel((const void*)fwd_megakernel, dim3(grid_blocks), dim3(NTHREADS), args, LDS_BYTES, stream);
    if (er != hipSuccess) fprintf(stderr, "cooperative launch failed: %s (grid %d)\n", hipGetErrorString(er), grid_blocks);
}
```

```cpp
#include <hip/hip_runtime.h>
#ifndef PROBE
#define PROBE 0
#endif
#define DUP(bit, stmt) do { stmt; if (PROBE & (bit)) { stmt; } } while (0)
#define GSYNC() do { unsigned* bw_ = (unsigned*)(p.ws + WS_BAR); asm volatile("" : "+s"(bw_)); XcdBarrier b_; b_.bar = bw_; b_.x = xb_xcc_id(); b_.st = (volatile LAS unsigned*)(lds + LDS_BYTES - 16); xcd_barrier(b_); if (PROBE & 128) xcd_barrier(b_); } while (0)
#include <hip/hip_cooperative_groups.h>
#include <cstdio>
#include <type_traits>
namespace cg = cooperative_groups;

#define LAS __attribute__((address_space(3)))
typedef unsigned short u16;
typedef short bf16x8 __attribute__((ext_vector_type(8)));
typedef float f32x4 __attribute__((ext_vector_type(4)));
typedef unsigned u32x4 __attribute__((ext_vector_type(4)));
typedef unsigned u32x2 __attribute__((ext_vector_type(2)));
typedef LAS unsigned char* ldsp;

constexpr int D = 1024, NCTX = 8192, NLAT = 32768, NTOK = 40960;
constexpr int NG = 2, CTXG = 4096, LATG = 16384, MG = 20480;
constexpr int EVP = 3600, EVPAD = 3840, EVR = 2064  , ODP = 6208, ODPAD = 6400, FH = 2816;
constexpr int NTHREADS = 512;
constexpr int LDS_BYTES = 160 * 1024;
constexpr float EPS = 1e-6f;

constexpr size_t OUT_C = 41943040ull, OUT_N = 50331648ull, OUT_M = 50397184ull, OUT_SSD = 50397696ull;

constexpr size_t MiB = 1048576ull;
constexpr size_t WS_MODP = 0, WS_MOD = 4 * MiB, WS_NST = 5 * MiB, WS_SC = 7 * MiB, WS_BAR = 7 * MiB + 512 * 1024, WS_MSC = 7 * MiB + 256 * 1024;
constexpr size_t WS_WT = 8 * MiB, WT_IN = WS_WT, WT_OUT = WS_WT + 13 * MiB, WT_F13 = WS_WT + 17 * MiB, WT_F2 = WS_WT + 28 * MiB;
constexpr size_t WS_KERNL = 44 * MiB, WS_KERNC = 77 * MiB;
constexpr size_t EV_H = 80 * MiB, EV_PROJT = 120 * MiB, EV_PROJR = 180 * MiB, EV_Y = 261 * MiB, EV_ST = 341 * MiB;
constexpr size_t EV_RAWL = 421 * MiB, EV_RAWC = 453 * MiB, EV_FSUM = 456 * MiB, EV_YT = 458 * MiB;
constexpr size_t OD_H = 44 * MiB, OD_SEG = 44 * MiB, OD_ZD = 100 * MiB, OD_RAW = 183 * MiB, OD_YF = 183 * MiB, OD_YB = 263 * MiB, OD_ACT = 343 * MiB, OD_DSEG = WS_NST;
constexpr int ZDL = 2112;
constexpr size_t FF_H = 44 * MiB, FF_U = 124 * MiB;

struct Params { const float* in[37]; float* out; unsigned char* ws; };
enum { I_XP = 0, I_XS, I_SC, I_SN, I_SM, I_SSD, I_C, I_CCTX, I_MODW, I_MODB, I_N1G, I_N2G, I_W1, I_W3, I_W2, I_FG, I_EVIN, I_EVCW, I_EVCB,
       I_HW1, I_HB1, I_HW2, I_HB2, I_HW3, I_HFREQ, I_HBIAS, I_MGB, I_MNG, I_EVOUT, I_ODIN, I_ODCW, I_ODCB, I_DTB, I_ALOG, I_SSDD, I_SSDNG, I_ODOUT };

typedef float f32x2 __attribute__((ext_vector_type(2)));
typedef __bf16 bf16x2_t __attribute__((ext_vector_type(2)));
__device__ __forceinline__ u16 f2bf(float f) { const __bf16 h = (__bf16)f; return __builtin_bit_cast(u16, h); }
__device__ __forceinline__ float bf2f(u16 b) { return __uint_as_float(((unsigned)b) << 16); }
__device__ __forceinline__ unsigned pk2(float a, float b) { const f32x2 v = {a, b}; const bf16x2_t r = __builtin_convertvector(v, bf16x2_t); return __builtin_bit_cast(unsigned, r); }
__device__ __forceinline__ float siluf(float x) { return x * __builtin_amdgcn_rcpf(1.0f + __expf(-x)); }
__device__ __forceinline__ float sigmf(float x) { return __builtin_amdgcn_rcpf(1.0f + __expf(-x)); }
__device__ __forceinline__ float softplusf(float x) { return fmaxf(x, 0.f) + __logf(1.0f + __expf(-fabsf(x))); }
__device__ __forceinline__ float logsigf(float x) { return fminf(x, 0.f) - __logf(1.0f + __expf(-fabsf(x))); }
__device__ __forceinline__ void unpack8(u32x4 v, float* f) {
    f[0] = __uint_as_float(v.x << 16); f[1] = __uint_as_float(v.x & 0xffff0000u); f[2] = __uint_as_float(v.y << 16); f[3] = __uint_as_float(v.y & 0xffff0000u);
    f[4] = __uint_as_float(v.z << 16); f[5] = __uint_as_float(v.z & 0xffff0000u); f[6] = __uint_as_float(v.w << 16); f[7] = __uint_as_float(v.w & 0xffff0000u); }
__device__ __forceinline__ void ld8(const u16* p, float* f) { unpack8(*(const u32x4*)p, f); }
__device__ __forceinline__ void ld8f(const float* p, float* f) { f32x4 a = *(const f32x4*)p, b = *(const f32x4*)(p + 4); f[0]=a[0];f[1]=a[1];f[2]=a[2];f[3]=a[3];f[4]=b[0];f[5]=b[1];f[6]=b[2];f[7]=b[3]; }
__device__ __forceinline__ void conv8(const u16* rowp, int ld, bool hasPrev, bool hasNext, const float* w, int cw, const float* b, int ci, float* out) {
    float p0[8], pm[8], pp[8], w0[8], w1[8], w2[8], bb[8];
    ld8(rowp, p0);
    if (hasPrev) ld8(rowp - ld, pm); else { for (int j = 0; j < 8; ++j) pm[j] = 0.f; }
    if (hasNext) ld8(rowp + ld, pp); else { for (int j = 0; j < 8; ++j) pp[j] = 0.f; }
    ld8f(w + ci, w0); ld8f(w + cw + ci, w1); ld8f(w + 2 * cw + ci, w2); ld8f(b + ci, bb);
#pragma unroll
    for (int j = 0; j < 8; ++j) out[j] = bb[j] + w0[j] * pm[j] + w1[j] * p0[j] + w2[j] * pp[j];
}
__device__ __forceinline__ bf16x8 ldfrag(const LAS u16* base, int off) { return *(const LAS bf16x8*)(base + off); }
#define MFMA(a, b, c) __builtin_amdgcn_mfma_f32_16x16x32_bf16((a), (b), (c), 0, 0, 0)

__device__ __forceinline__ int tid_opaque() { int t; asm volatile("v_mov_b32 %0, %1" : "=v"(t) : "v"((int)threadIdx.x)); return t; }
__device__ __forceinline__ int grow_of(int g, int r) { return r < CTXG ? g * CTXG + r : NCTX + g * LATG + (r - CTXG); }
__device__ __forceinline__ int cond_of(int g, int r) { return r < CTXG ? 0 : 1 + g * 4 + ((r - CTXG) >> 12); }
__device__ __forceinline__ int cond_of_global(int gr) { return gr < NCTX ? 0 : 1 + ((gr - NCTX) >> 12); }
__device__ __forceinline__ int perm_row(int r, bool colmajor) {
    if (!colmajor || r < CTXG) return r;
    const int q = r - CTXG, s = q >> 12, i = q & 4095;
    return CTXG + (s << 12) + ((i & 63) << 6) + (i >> 6);
}

namespace pg8 {
constexpr int BM = 256, BK = 64, HALF = 128, HTB = HALF * BK * 2, STAGE_BYTES = 8 * HTB, NXCD = 8, WGM = 8;
__device__ __forceinline__ int lds_byte(int r, int c) { const int st = (r >> 4) * 2 + (c >> 5), rr = r & 15, cc = c & 31, ob = rr * 64 + cc * 2; return st * 1024 + (ob ^ (((ob >> 9) & 1) << 5)); }
__device__ __forceinline__ void stage_rc(int b, int& R, int& C) { const int st = b / 1024, sb = b % 1024, swz = sb ^ (((sb >> 9) & 1) << 5); R = (st >> 1) * 16 + swz / 64; C = (st & 1) * 32 + (swz % 64) / 2; }
struct Unit { int pm, pn; };
struct Gemm { const u16* A; const u16* Bt; int M, N, K; };
struct StaticOrder {
    int nM, nN, nwg, G, c;
    __device__ void init(int M, int N, int G_, int c_) { nM = M / BM; nN = N / BM; nwg = nM * nN; G = G_; c = c_; }
    __device__ bool next(int i, Unit& u) const {
        const long L = (long)i * G + c; if (L >= nwg) return false;
        int wgid = (int)L; { const int q = nwg / NXCD, r = nwg % NXCD, xcd = wgid % NXCD, off = wgid / NXCD; wgid = (xcd < r ? xcd * (q + 1) : r * (q + 1) + (xcd - r) * q) + off; }
        const int nig = WGM * nN, gid = wgid / nig, fm = gid * WGM, gsz = (nM - fm) < WGM ? (nM - fm) : WGM;
        u.pm = fm + ((wgid % nig) % gsz); u.pn = (wgid % nig) / gsz; return true;
    }
};
template <class Epi>
__device__ __forceinline__ void gemm_phase(ldsp lds, const Gemm g, const StaticOrder& S, const Epi& E) {
    const int tid = tid_opaque(), wid = __builtin_amdgcn_readfirstlane(tid >> 6), lane = tid & 63, wr = wid >> 2, wc = wid & 3, fr = lane & 15, fq = lane >> 4;
    const int K = g.K, nt = K / BK;
    unsigned voffA[2];
#pragma unroll
    for (int i = 0; i < 2; ++i) { int R, C; stage_rc(tid * 16 + i * 8192, R, C); voffA[i] = (unsigned)(R * K + C) * 2u; }
    const size_t kstep = (size_t)(BK * 2);
    const size_t hstep = (size_t)HALF * K * 2;
    const size_t tstep = 2 * hstep;
    const unsigned ldsw = (unsigned)wid * 1024u;
    const int aoff = lds_byte(wr * 64 + fr, fq * 8), boff = lds_byte(wc * 32 + fr, fq * 8);
#define PG8_SA(b, h) (((b) * 2 + (h)) * HTB)
#define PG8_SB(b, h) ((4 + (b) * 2 + (h)) * HTB)
#define PG8_STAGE(bufoff, gbase, voff) do { _Pragma("unroll") for (int _i = 0; _i < 2; ++_i) \
        __builtin_amdgcn_global_load_lds((const unsigned*)((const char*)(gbase) + (voff)[_i]), (LAS unsigned*)(lds + (bufoff) + ldsw + _i * 8192), 16, 0, 0); } while (0)
#define PG8_LDA(dst, b, h) do { _Pragma("unroll") for (int m = 0; m < 4; ++m) _Pragma("unroll") for (int k = 0; k < 2; ++k) dst[m][k] = *(const LAS bf16x8*)(lds + PG8_SA(b, h) + aoff + m * 2048 + k * 1024); } while (0)
#define PG8_LDB(dst, b, h) do { _Pragma("unroll") for (int n = 0; n < 2; ++n) _Pragma("unroll") for (int k = 0; k < 2; ++k) dst[n][k] = *(const LAS bf16x8*)(lds + PG8_SB(b, h) + boff + n * 2048 + k * 1024); } while (0)
#define PG8_MMA(ai, bj, At, Bt) do { __builtin_amdgcn_s_setprio(1); _Pragma("unroll") for (int m = 0; m < 4; ++m) _Pragma("unroll") for (int n = 0; n < 2; ++n) _Pragma("unroll") for (int k = 0; k < 2; ++k) \
        acc[ai][bj][m][n] = __builtin_amdgcn_mfma_f32_16x16x32_bf16(Bt[n][k], At[m][k], acc[ai][bj][m][n], 0, 0, 0); __builtin_amdgcn_s_setprio(0); } while (0)
#define PG8_WAIT_V(n) asm volatile("s_waitcnt vmcnt(" #n ")" ::: "memory")
#define PG8_WAIT_L(n) asm volatile("s_waitcnt lgkmcnt(" #n ")" ::: "memory")
#define PG8_BAR __builtin_amdgcn_s_barrier()
#define PG8_SCHED __builtin_amdgcn_sched_barrier(0)
    Unit cur, nxt; int ui = 0;
    if (!S.next(0, cur)) return;
    f32x4 acc[2][2][4][2];
#pragma unroll
    for (int a = 0; a < 2; ++a)
#pragma unroll
        for (int b = 0; b < 2; ++b)
#pragma unroll
            for (int m = 0; m < 4; ++m)
#pragma unroll
                for (int n = 0; n < 2; ++n) acc[a][b][m][n] = (f32x4){0.f, 0.f, 0.f, 0.f};
    bf16x8 At[4][2], B0[2][2], B1[2][2];
    const char* cA = (const char*)g.A + (size_t)cur.pm * tstep; const char* cB = (const char*)g.Bt + (size_t)cur.pn * tstep;
    PG8_STAGE(PG8_SB(0, 0), cB, voffA); PG8_STAGE(PG8_SA(0, 0), cA, voffA); PG8_STAGE(PG8_SB(0, 1), cB + hstep, voffA); PG8_STAGE(PG8_SA(0, 1), cA + hstep, voffA);
    if (wr == 1) PG8_BAR;
    PG8_WAIT_V(4); PG8_BAR;
    PG8_STAGE(PG8_SB(1, 0), cB + kstep, voffA); PG8_STAGE(PG8_SA(1, 0), cA + kstep, voffA); PG8_STAGE(PG8_SB(1, 1), cB + hstep + kstep, voffA);
    PG8_WAIT_V(6); PG8_BAR;
    for (;;) {
        const bool has_next = S.next(ui + 1, nxt);
        const char* nA = has_next ? (const char*)g.A + (size_t)nxt.pm * tstep : cA; const char* nB = has_next ? (const char*)g.Bt + (size_t)nxt.pn * tstep : cB;
        for (int t = 0; t < nt; t += 2) {
            const bool last = (t == nt - 2);
            const char* a1 = cA + (size_t)(t + 1) * kstep;
            const char* a2 = last ? nA : cA + (size_t)(t + 2) * kstep; const char* b2 = last ? nB : cB + (size_t)(t + 2) * kstep;
            const char* a3 = a2 + kstep; const char* b3 = b2 + kstep;
            PG8_LDB(B0, 0, 0); PG8_SCHED; PG8_LDA(At, 0, 0); PG8_STAGE(PG8_SA(1, 1), a1 + hstep, voffA);
            PG8_WAIT_L(8); PG8_BAR; PG8_WAIT_L(0); PG8_MMA(0, 0, At, B0); PG8_BAR; PG8_SCHED;
            PG8_LDB(B1, 0, 1); PG8_STAGE(PG8_SB(0, 0), b2, voffA);
            PG8_BAR; PG8_WAIT_L(0); PG8_MMA(0, 1, At, B1); PG8_BAR;
            PG8_LDA(At, 0, 1); PG8_STAGE(PG8_SA(0, 0), a2, voffA);
            PG8_BAR; PG8_WAIT_L(0); PG8_MMA(1, 0, At, B0); PG8_BAR; PG8_SCHED;
            PG8_STAGE(PG8_SB(0, 1), b2 + hstep, voffA);
            PG8_WAIT_V(6); PG8_BAR; PG8_MMA(1, 1, At, B1); PG8_BAR;
            PG8_LDB(B0, 1, 0); PG8_SCHED; PG8_LDA(At, 1, 0); PG8_STAGE(PG8_SA(0, 1), a2 + hstep, voffA);
            PG8_WAIT_L(8); PG8_BAR; PG8_WAIT_L(0); PG8_MMA(0, 0, At, B0); PG8_BAR; PG8_SCHED;
            PG8_LDB(B1, 1, 1); PG8_STAGE(PG8_SB(1, 0), b3, voffA);
            PG8_BAR; PG8_WAIT_L(0); PG8_MMA(0, 1, At, B1); PG8_BAR;
            PG8_LDA(At, 1, 1); PG8_STAGE(PG8_SA(1, 0), a3, voffA);
            PG8_BAR; PG8_WAIT_L(0); PG8_MMA(1, 0, At, B0); PG8_BAR; PG8_SCHED;
            PG8_STAGE(PG8_SB(1, 1), b3 + hstep, voffA);
            PG8_WAIT_V(6); PG8_BAR; PG8_MMA(1, 1, At, B1); PG8_BAR;
        }
        E(acc, cur, wr, wc, fr, fq);
        if (!has_next) break;
#pragma unroll
        for (int a = 0; a < 2; ++a)
#pragma unroll
            for (int b = 0; b < 2; ++b)
#pragma unroll
                for (int m = 0; m < 4; ++m)
#pragma unroll
                    for (int n = 0; n < 2; ++n) acc[a][b][m][n] = (f32x4){0.f, 0.f, 0.f, 0.f};
        cur = nxt; cA = nA; cB = nB; ++ui;
    }
    PG8_WAIT_V(0);
    if (wr == 0) PG8_BAR;
    PG8_BAR;
#undef PG8_SA
#undef PG8_SB
#undef PG8_STAGE
#undef PG8_LDA
#undef PG8_LDB
#undef PG8_MMA
#undef PG8_WAIT_V
#undef PG8_WAIT_L
#undef PG8_BAR
#undef PG8_SCHED
}
}

typedef const f32x4 (&AccRef)[2][2][4][2];
#define EPI_LOOP_BEGIN \
    _Pragma("unroll") for (int ai = 0; ai < 2; ++ai) _Pragma("unroll") for (int m = 0; m < 4; ++m) { const int row = u.pm * 256 + ai * 128 + wr * 64 + m * 16 + fr;
#define EPI_COLS_BEGIN \
    _Pragma("unroll") for (int bj = 0; bj < 2; ++bj) _Pragma("unroll") for (int n = 0; n < 2; ++n) { const int col = u.pn * 256 + bj * 128 + wc * 32 + n * 16 + 4 * fq; const f32x4 v = acc[ai][bj][m][n];

struct EpiProjEven {
    u16* projT; u16* projR;
    __device__ __forceinline__ void operator()(AccRef acc, const pg8::Unit& u, int wr, int wc, int fr, int fq) const {
        EPI_LOOP_BEGIN EPI_COLS_BEGIN
            if (col < 1536) {
#pragma unroll
                for (int j = 0; j < 4; ++j) projT[(size_t)(col + j) * MG + row] = f2bf(v[j]);
            } else if (col < EVP) {
                u32x2 w; w.x = pk2(v[0], v[1]); w.y = pk2(v[2], v[3]);
                *(u32x2*)(projR + (size_t)row * EVR + (col - 1536)) = w;
            }
        } }
    }
};
struct EpiProjOdd {
    u16* zd; u16* raw;
    __device__ __forceinline__ void operator()(AccRef acc, const pg8::Unit& u, int wr, int wc, int fr, int fq) const {
        EPI_LOOP_BEGIN EPI_COLS_BEGIN
            u32x2 w; w.x = pk2(v[0], v[1]); w.y = pk2(v[2], v[3]);
            if (col < 2048) *(u32x2*)(zd + (size_t)row * ZDL + col) = w;
            else if (col < 6144) *(u32x2*)(raw + (size_t)row * 4096 + (col - 2048)) = w;
            else if (col < ODP) *(u32x2*)(zd + (size_t)row * ZDL + 2048 + (col - 6144)) = w;
        } }
    }
};
struct EpiResid {
    float* x; const float* mod; const float* xp0; const float* xs0; int l, gidx, g; bool colmajor, grouped, first;
    __device__ __forceinline__ void operator()(AccRef acc, const pg8::Unit& u, int wr, int wc, int fr, int fq) const {
        EPI_LOOP_BEGIN
            int grow, cond;
            if (grouped) { const int gg = g + (row >= MG ? 1 : 0); const int r = perm_row(row >= MG ? row - MG : row, colmajor); grow = grow_of(gg, r); cond = cond_of(gg, r); }
            else { grow = row; cond = cond_of_global(row); }
            const float* gp = mod + ((size_t)(l * 9 + cond) * 6 + gidx) * 1024;
            float* xp = x + (size_t)grow * 1024;
            const float* xi = first ? (grow < NCTX ? xp0 + (size_t)grow * 1024 : xs0 + (size_t)(grow - NCTX) * 1024) : xp;
            EPI_COLS_BEGIN
                const f32x4 gt = *(const f32x4*)(gp + col); f32x4 xv = *(const f32x4*)(xi + col);
                xv = xv + gt * v; *(f32x4*)(xp + col) = xv;
            }
        }
    }
};
struct EpiSwiGLU {
    u16* uo;
    __device__ __forceinline__ void operator()(AccRef acc, const pg8::Unit& u, int wr, int wc, int fr, int fq) const {
        EPI_LOOP_BEGIN
#pragma unroll
            for (int bj = 0; bj < 2; ++bj) {
                const int hc = (u.pn * 256 + bj * 128 + wc * 32) / 2 + 4 * fq;
                const f32x4 a = acc[ai][bj][m][0], b = acc[ai][bj][m][1];
                u32x2 w; w.x = pk2(siluf(a[0]) * b[0], siluf(a[1]) * b[1]); w.y = pk2(siluf(a[2]) * b[2], siluf(a[3]) * b[3]);
                *(u32x2*)(uo + (size_t)row * FH + hc) = w;
            }
        }
    }
};

template <class Epi>
__device__ __forceinline__ void run_gemm(ldsp lds, const u16* A, const u16* Bt, int M, int N, int K, const Epi& E) {
    pg8::Gemm g; g.A = A; g.Bt = Bt; g.M = M; g.N = N; g.K = K;
    pg8::StaticOrder S; S.init(M, N, (int)gridDim.x, (int)blockIdx.x);
    pg8::gemm_phase<Epi>(lds, g, S, E);
}

__device__ __forceinline__ void ph_copyx(const Params& p) {
    const f32x4* a = (const f32x4*)p.in[I_XP]; const f32x4* b = (const f32x4*)p.in[I_XS]; f32x4* o = (f32x4*)p.out;
    const size_t n0 = (size_t)NCTX * 256, n1 = (size_t)NTOK * 256;
    for (size_t i = (size_t)blockIdx.x * NTHREADS + tid_opaque(); i < n1; i += (size_t)gridDim.x * NTHREADS) o[i] = i < n0 ? a[i] : b[i - n0];
}
__device__ __forceinline__ void ph_modp(const Params& p, ldsp lds) {
    LAS float* s = (LAS float*)lds;
    float* modp = (float*)(p.ws + WS_MODP);
    const int t = tid_opaque();
    for (int it = blockIdx.x; it < 192; it += gridDim.x) {
        const int l = it / 48, rem = it % 48, cc = rem >> 2, ks = rem & 3;
        __syncthreads();
        for (int idx = t; idx < 9 * 256; idx += NTHREADS) { const int r = idx >> 8, k = idx & 255;
            const float cv = r == 0 ? p.in[I_CCTX][ks * 256 + k] : p.in[I_C][(r - 1) * 1024 + ks * 256 + k]; s[idx] = siluf(cv); }
        __syncthreads();
        const int col = cc * 512 + t;
        float acc[9];
#pragma unroll
        for (int r = 0; r < 9; ++r) acc[r] = 0.f;
        const float* w = p.in[I_MODW] + ((size_t)l * 1024 + ks * 256) * 6144 + col;
#pragma unroll 8
        for (int k = 0; k < 256; ++k) { const float wv = w[(size_t)k * 6144];
#pragma unroll
            for (int r = 0; r < 9; ++r) acc[r] += s[r * 256 + k] * wv; }
#pragma unroll
        for (int r = 0; r < 9; ++r) modp[((size_t)(ks * 4 + l) * 9 + r) * 6144 + col] = acc[r];
    }
}
__device__ __forceinline__ void ph_modfin(const Params& p) {
    const float* modp = (const float*)(p.ws + WS_MODP); float* mod = (float*)(p.ws + WS_MOD);
    for (int idx = blockIdx.x * NTHREADS + tid_opaque(); idx < 221184; idx += gridDim.x * NTHREADS) {
        const int l = idx / (9 * 6144), col = idx % 6144;
        mod[idx] = modp[idx] + modp[221184 + idx] + modp[2 * 221184 + idx] + modp[3 * 221184 + idx] + p.in[I_MODB][l * 6144 + col];
    }
}
__device__ __forceinline__ void ph_wconv(ldsp lds, const float* src, const float* src2, int K, int Nsrc, int Npad, int mode, u16* dst) {
    const int t = tid_opaque(), wid = __builtin_amdgcn_readfirstlane(t >> 6), lane = t & 63, nkt = K / 64, ntiles = (Npad / 64) * nkt;
    for (int it = blockIdx.x; it < ntiles; it += gridDim.x) {
        const int n = (it / nkt) * 64 + 8 * wid + (lane >> 3), k = (it % nkt) * 64 + (lane & 7) * 8;
        const float* sp; int sc; bool valid = true;
        if (mode == 0) { sp = src; sc = n; valid = n < Nsrc; } else { sp = ((n >> 4) & 1) ? src2 : src; sc = (n >> 5) * 16 + (n & 15); }
        float v[8];
#pragma unroll
        for (int j = 0; j < 8; ++j) v[j] = valid ? sp[(size_t)(k + j) * Nsrc + sc] : 0.f;
        u32x4 w; w.x = pk2(v[0], v[1]); w.y = pk2(v[2], v[3]); w.z = pk2(v[4], v[5]); w.w = pk2(v[6], v[7]);
        *(u32x4*)(dst + (size_t)n * K + k) = w;
    }
}
__device__ __forceinline__ void ph_wconv_layer(const Params& p, ldsp lds, int l) {
    const int e = l >> 1;
    if ((l & 1) == 0) {
        ph_wconv(lds, p.in[I_EVIN] + (size_t)e * 1024 * EVP, nullptr, 1024, EVP, EVPAD, 0, (u16*)(p.ws + WT_IN));
        ph_wconv(lds, p.in[I_EVOUT] + (size_t)e * 1024 * 1024, nullptr, 1024, 1024, 1024, 0, (u16*)(p.ws + WT_OUT));
    } else {
        ph_wconv(lds, p.in[I_ODIN] + (size_t)e * 1024 * ODP, nullptr, 1024, ODP, ODPAD, 0, (u16*)(p.ws + WT_IN));
        ph_wconv(lds, p.in[I_ODOUT] + (size_t)e * 2048 * 1024, nullptr, 2048, 1024, 1024, 0, (u16*)(p.ws + WT_OUT));
    }
    ph_wconv(lds, p.in[I_W1] + (size_t)l * 1024 * FH, p.in[I_W3] + (size_t)l * 1024 * FH, 1024, FH, 2 * FH, 1, (u16*)(p.ws + WT_F13));
    ph_wconv(lds, p.in[I_W2] + (size_t)l * FH * 1024, nullptr, FH, 1024, 1024, 0, (u16*)(p.ws + WT_F2));
}

__device__ __forceinline__ void ph_filt_raw(const Params& p, ldsp lds, int e) {
    LAS float* h1 = (LAS float*)lds; LAS float* h2 = h1 + 64 * 65; LAS float* ft = h2 + 64 * 65;
    const int t = tid_opaque(), pos = t & 63, jg = t >> 6;
    const float* w1 = p.in[I_HW1] + e * 33 * 64; const float* b1 = p.in[I_HB1] + e * 64; const float* w2 = p.in[I_HW2] + e * 64 * 64; const float* b2 = p.in[I_HB2] + e * 64;
    const float* w3 = p.in[I_HW3] + (size_t)e * 64 * 2048; const float* fr = p.in[I_HFREQ] + e * 64;
    for (int it4 = blockIdx.x; it4 < 272; it4 += gridDim.x) {
        const int it = it4 >> 2, ci = it4 & 3;
        const bool isc = it < 4; const int L = isc ? 256 : 4096, lb = isc ? it : it - 4;
        float* raw = (float*)(p.ws + (isc ? EV_RAWC : EV_RAWL));
        const float invLm1 = 1.0f / (float)(L - 1);
        __syncthreads();
        {
            const int l = lb * 64 + pos; const float tt = (float)l * invLm1;
            const float w0 = 6.283185307179586f / (float)L;
            if (jg == 0) ft[pos * 33] = tt;
#pragma unroll 1
            for (int bb = 0; bb < 2; ++bb) { const int b = jg * 2 + bb; const float band = 1e-4f + (float)b * ((15.0f - 1e-4f) / 15.0f); const float ang = (w0 * (float)l) * band; ft[pos * 33 + 1 + b] = cosf(ang); ft[pos * 33 + 17 + b] = -sinf(ang); }
        }
        __syncthreads();
        {
#pragma unroll 1
            for (int ju = 0; ju < 8; ++ju) { const int j = jg * 8 + ju; float a = b1[j];
#pragma unroll 11
                for (int i = 0; i < 33; ++i) a += ft[pos * 33 + i] * w1[i * 64 + j];
                h1[pos * 65 + j] = sinf(fr[j] * a); }
        }
        __syncthreads();
        {
#pragma unroll 1
            for (int ju = 0; ju < 8; ++ju) { const int j = jg * 8 + ju; float a = b2[j];
#pragma unroll 16
                for (int i = 0; i < 64; ++i) a += h1[pos * 65 + i] * w2[i * 64 + j];
                h2[pos * 65 + j] = sinf(fr[j] * a); }
        }
        __syncthreads();
        {
            const int col = t + 512 * ci, c = col & 511;
            float wv[64];
#pragma unroll
            for (int k = 0; k < 64; ++k) wv[k] = w3[(size_t)k * 2048 + col];
            const float a0 = -4.605170185988091f / 1.5f, a1 = -4.605170185988091f / 0.3f;
            const float delta = fabsf(a0 + (float)c * ((a1 - a0) / 511.0f));
            float asum = 0.f;
#pragma unroll 1
            for (int q = 0; q < 64; ++q) {
                float a = 0.f;
#pragma unroll
                for (int k = 0; k < 64; ++k) a += h2[q * 65 + k] * wv[k];
                const int lp = lb * 64 + q; const float tp = (float)lp * invLm1;
                const float val = a * expf(-tp * delta);
                raw[(size_t)lp * 2048 + col] = val;
                if (!(lp == 0 && col >= 1024)) asum += fabsf(val);
            }
            ((float*)(p.ws + EV_FSUM))[it * 2048 + col] = asum;
        }
    }
}
__device__ __forceinline__ void ph_filt_norm(const Params& p, ldsp lds) {
    LAS float* tile = (LAS float*)lds; LAS float* inv = tile + 64 * 65;
    const int t = tid_opaque(), cc = t & 63, lg = t >> 6;
    const float* fsum = (const float*)(p.ws + EV_FSUM);
    for (int it = blockIdx.x; it < 544; it += gridDim.x) {
        const bool isc = it >= 512; int o, cb, dir, lc, L;
        if (isc) { const int i2 = it - 512; o = i2 >> 4; cb = (i2 >> 1) & 7; dir = i2 & 1; lc = 0; L = 256; }
        else { o = it >> 8; cb = (it >> 5) & 7; dir = (it >> 4) & 1; lc = it & 15; L = 4096; }
        const int c0 = cb * 64;
        const float* raw = (const float*)(p.ws + (isc ? EV_RAWC : EV_RAWL)); u16* kern = (u16*)(p.ws + (isc ? WS_KERNC : WS_KERNL)); const int RLD = 2 * L + 8;
        if (lc == (isc ? 0 : 15) && t < 64) { u16* im = kern + (size_t)(o * 512 + c0 + t) * 2 * RLD; unsigned zz; asm volatile("v_mov_b32 %0, 0" : "=v"(zz)); const u16 z16 = (u16)zz;
            if (dir == 0) im[0] = z16; else {
#pragma unroll 1
                for (int y = 2 * L - 1; y < RLD; ++y) { if (y >= 2 * L) im[y] = z16; im[RLD + y] = z16; } } }
        __syncthreads();
        if (t < 64) { float sm = 0.f; const int nlb = isc ? 4 : 64, lb0 = isc ? 0 : 4;
            for (int q = 0; q < nlb; ++q) sm += fsum[(lb0 + q) * 2048 + o * 512 + c0 + t] + fsum[(lb0 + q) * 2048 + 1024 + o * 512 + c0 + t];
            inv[t] = 1.0f / sm; }
        __syncthreads();
        for (int l0 = lc * 256; l0 < lc * 256 + 256; l0 += 64) {
#pragma unroll
            for (int i = 0; i < 8; ++i) { const int ll = lg * 8 + i; float v = raw[(size_t)(l0 + ll) * 2048 + dir * 1024 + o * 512 + c0 + cc] * inv[cc]; if (dir == 1 && l0 + ll == 0) v = 0.f; tile[ll * 65 + cc] = v; }
            __syncthreads();
            { const int cw_ = t >> 3, ls = (t & 7) * 8; u16* im = kern + (size_t)(o * 512 + c0 + cw_) * 2 * RLD;
#pragma unroll
              for (int j = 0; j < 8; ++j) { const int l = l0 + ls + j; const u16 hv = f2bf(tile[(ls + j) * 65 + cw_]);
                  if (dir == 0) { im[L - l] = hv; im[RLD + L - l - 1] = hv; }
                  else if (l > 0) { im[L + l] = hv; im[RLD + L + l - 1] = hv; } } }
            __syncthreads();
        }
    }
}

__device__ __forceinline__ void ph_norm(const Params& p, int l, int which, bool grouped, int g, bool colmajor, u16* hdst, int bstart = 0, int bcount = 0, bool dglobal = false) {
    const int t = tid_opaque(), wid = __builtin_amdgcn_readfirstlane(t >> 6), lane = t & 63;
    const float* gam = p.in[which ? I_N2G : I_N1G] + l * 1024; const float* mod = (const float*)(p.ws + WS_MOD);
    const int nrows = grouped ? MG : NTOK;
    if (bcount == 0) bcount = (int)gridDim.x;
    if ((int)blockIdx.x < bstart) return;
    for (int r = ((int)blockIdx.x - bstart) * 8 + wid; r < nrows; r += bcount * 8) {
        int grow, cond, drow;
        if (grouped) { grow = grow_of(g, r); cond = cond_of(g, r); drow = dglobal ? grow : perm_row(r, colmajor); } else { grow = r; cond = cond_of_global(r); drow = r; }
        const float* xp = (l == 0 && which == 0) ? (grow < NCTX ? p.in[I_XP] + (size_t)grow * 1024 : p.in[I_XS] + (size_t)(grow - NCTX) * 1024) : p.out + (size_t)grow * 1024;
        const float* sh = mod + ((size_t)(l * 9 + cond) * 6 + (which ? 3 : 0)) * 1024; const float* sc = sh + 1024;
        f32x4 xv[4]; float ss = 0.f;
#pragma unroll
        for (int i = 0; i < 4; ++i) { xv[i] = *(const f32x4*)(xp + i * 256 + lane * 4); ss += xv[i][0] * xv[i][0] + xv[i][1] * xv[i][1] + xv[i][2] * xv[i][2] + xv[i][3] * xv[i][3]; }
#pragma unroll
        for (int o = 32; o > 0; o >>= 1) ss += __shfl_xor(ss, o);
        const float rstd = rsqrtf(ss * (1.0f / 1024.0f) + EPS);
#pragma unroll
        for (int i = 0; i < 4; ++i) { const int c = i * 256 + lane * 4; const f32x4 gv = *(const f32x4*)(gam + c), sv = *(const f32x4*)(sc + c), hv = *(const f32x4*)(sh + c);
            f32x4 y = xv[i] * rstd * gv * (sv + 1.0f) + hv; u32x2 w; w.x = pk2(y[0], y[1]); w.y = pk2(y[2], y[3]);
            *(u32x2*)(hdst + (size_t)drow * 1024 + c) = w; }
    }
}
__device__ __forceinline__ void ph_final(const Params& p) {
    const int t = tid_opaque(), wid = __builtin_amdgcn_readfirstlane(t >> 6), lane = t & 63; const float* gam = p.in[I_FG];
    for (int r = blockIdx.x * 8 + wid; r < NTOK; r += gridDim.x * 8) {
        float* xp = p.out + (size_t)r * 1024; f32x4 xv[4]; float ss = 0.f;
#pragma unroll
        for (int i = 0; i < 4; ++i) { xv[i] = *(const f32x4*)(xp + i * 256 + lane * 4); ss += xv[i][0] * xv[i][0] + xv[i][1] * xv[i][1] + xv[i][2] * xv[i][2] + xv[i][3] * xv[i][3]; }
#pragma unroll
        for (int o = 32; o > 0; o >>= 1) ss += __shfl_xor(ss, o);
        const float rstd = rsqrtf(ss * (1.0f / 1024.0f) + EPS);
#pragma unroll
        for (int i = 0; i < 4; ++i) { const int c = i * 256 + lane * 4; *(f32x4*)(xp + c) = xv[i] * rstd * *(const f32x4*)(gam + c); }
    }
}

template <int L, int NB>
__device__ __forceinline__ void hy_load_conv(LAS u16* dst, const u16* src, float w0, float w1, float w2, float bb, int t) {
    constexpr int ZLD = L + 8, NIT = NB * L / 8 / NTHREADS;
    u32x4 rv[NIT]; float pl[NIT], pn[NIT];
#pragma unroll
    for (int i = 0; i < NIT; ++i) { const int v = t + i * NTHREADS; const int sq = v / (L / 8), p8 = (v % (L / 8)) * 8; const u16* pr = src + sq * L + p8;
        rv[i] = *(const u32x4*)pr; pl[i] = p8 > 0 ? bf2f(pr[-1]) : 0.f; pn[i] = p8 < L - 8 ? bf2f(pr[8]) : 0.f; }
#pragma unroll
    for (int i = 0; i < NIT; ++i) { const int v = t + i * NTHREADS; const int sq = v / (L / 8), p8 = (v % (L / 8)) * 8;
        float pv[8]; unpack8(rv[i], pv);
        float o[8];
#pragma unroll
        for (int k = 0; k < 8; ++k) { const float a = k > 0 ? pv[k - 1] : pl[i], d = k < 7 ? pv[k + 1] : pn[i]; o[k] = bb + w0 * a + w1 * pv[k] + w2 * d; }
        u32x4 w; w.x = pk2(o[0], o[1]); w.y = pk2(o[2], o[3]); w.z = pk2(o[4], o[5]); w.w = pk2(o[6], o[7]);
        *(LAS u32x4*)(dst + sq * ZLD + p8) = w; }
}
template <int L, int NB, int NTW, int MTW>
__device__ __forceinline__ void hyena_item(const Params& p, ldsp lds, int e, int c, int rowbase) {
    constexpr int NT1 = L / 64, ZLD = L + 8, RLD = 2 * L + 8;
    LAS u16* Zs = (LAS u16*)lds; LAS u16* Xs = Zs + NB * ZLD; LAS u16* R0 = Xs + NB * ZLD; LAS u16* R1 = R0 + RLD;
    const int t = tid_opaque(), wid = __builtin_amdgcn_readfirstlane(t >> 6), lane = t & 63, fr = lane & 15, fq = lane >> 4;
    const int nt0 = (NTW == 2) ? 2 * wid : (wid >> 1), mt0 = (MTW == 4) ? 0 : 2 * (wid & 1);
    const u16* projT = (const u16*)(p.ws + EV_PROJT); u16* yT = (u16*)(p.ws + EV_YT);
    const float* cw = p.in[I_EVCW] + (size_t)e * 3 * 2560; const float* cbias = p.in[I_EVCB] + e * 2560;
    const u16* kern = (const u16*)(p.ws + (L == 256 ? WS_KERNC : WS_KERNL));
    __syncthreads();
    if (t < NB) { unsigned zz; asm volatile("v_mov_b32 %0, 0" : "=v"(zz)); u32x4 zv; zv.x = zz; zv.y = zz; zv.z = zz; zv.w = zz; *(LAS u32x4*)(Zs + t * ZLD + L) = zv; }
    hy_load_conv<L, NB>(Zs, projT + (size_t)c * MG + rowbase, cw[c], cw[2560 + c], cw[5120 + c], cbias[c], t);
    const LAS unsigned* rl = (const LAS unsigned*)((fr & 1) ? R1 : R0) + ((L - fr + 8 * fq - (fr & 1)) >> 1);
#pragma unroll 1
    for (int o = 0; o < 2; ++o) {
        { const int gc = (o + 1) * 512 + c; hy_load_conv<L, NB>(Xs, projT + (size_t)gc * MG + rowbase, cw[gc], cw[2560 + gc], cw[5120 + gc], cbias[gc], t); }
        { const u32x4* img = (const u32x4*)(kern + (size_t)(o * 512 + c) * 2 * RLD);
          for (int v = t; v < 2 * RLD / 8; v += NTHREADS) ((LAS u32x4*)R0)[v] = img[v]; }
        __syncthreads();
        f32x4 acc[NTW][MTW];
#pragma unroll
        for (int i = 0; i < NTW; ++i)
#pragma unroll
            for (int m = 0; m < MTW; ++m) acc[i][m] = (f32x4){0.f, 0.f, 0.f, 0.f};
        if constexpr (MTW == 4) {
            const int t1lo = (16 * nt0) / NB, t1hi = (16 * (nt0 + NTW - 1) + 15) / NB;
            const int dlo = (t1lo - (NT1 - 1)) > -(NT1 - 1) ? (t1lo - (NT1 - 1)) : -(NT1 - 1), dhi = t1hi < NT1 - 1 ? t1hi : NT1 - 1;
            bf16x8 F[10];
#pragma unroll
            for (int q = 0; q < 6; ++q) { const LAS unsigned* rp = rl - 8 * (4 * dlo - 2 + q); u32x4 v; v.x = rp[0]; v.y = rp[1]; v.z = rp[2]; v.w = rp[3]; F[q] = __builtin_bit_cast(bf16x8, v); }
#pragma unroll 1
            for (int db = dlo; db <= dhi; db += 5) {
#pragma unroll
                for (int S = 0; S < 5; ++S) {
                    const int d1 = db + S;
                    if (d1 <= dhi) {
#pragma unroll
                        for (int q = 0; q < 4; ++q) { const LAS unsigned* rp = rl - 8 * (4 * (d1 + 1) + q); u32x4 v; v.x = rp[0]; v.y = rp[1]; v.z = rp[2]; v.w = rp[3]; F[(4 * S + 6 + q) % 10] = __builtin_bit_cast(bf16x8, v); }
#pragma unroll
                        for (int i = 0; i < NTW; ++i) {
                            const int lo = (16 * (nt0 + i)) / NB - d1, hi = (16 * (nt0 + i) + 15) / NB - d1;
                            if (hi >= 0 && lo <= NT1 - 1) {
                                const int n = 16 * (nt0 + i) + fr, t1 = n / NB, b = n % NB, s1 = t1 - d1; const bool ok = (unsigned)s1 < (unsigned)NT1;
                                const LAS u16* zp = Zs + b * ZLD + (ok ? 64 * s1 + 8 * fq : L);
                                const bf16x8 b0 = *(const LAS bf16x8*)zp, b1 = *(const LAS bf16x8*)(zp + (ok ? 32 : 0));
#pragma unroll
                                for (int m = 0; m < MTW; ++m) { acc[i][m] = MFMA(F[(4 * S + m + 2) % 10], b0, acc[i][m]); acc[i][m] = MFMA(F[(4 * S + m) % 10], b1, acc[i][m]); }
                            }
                        }
                    }
                }
            }
        } else {
#pragma unroll 1
        for (int d1 = -(NT1 - 1); d1 <= NT1 - 1; ++d1) {
            bool valid[NTW]; bool any = false;
#pragma unroll
            for (int i = 0; i < NTW; ++i) { const int lo = (16 * (nt0 + i)) / NB - d1, hi = (16 * (nt0 + i) + 15) / NB - d1; valid[i] = hi >= 0 && lo <= NT1 - 1; any = any || valid[i]; }
            if (!any) continue;
            bf16x8 af[MTW + 2];
#pragma unroll
            for (int q = 0; q < MTW + 2; ++q) { const int delta = mt0 - 2 + q; const LAS unsigned* rp = rl - (32 * d1 + 8 * delta);
                u32x4 v; v.x = rp[0]; v.y = rp[1]; v.z = rp[2]; v.w = rp[3]; af[q] = __builtin_bit_cast(bf16x8, v); }
#pragma unroll
            for (int i = 0; i < NTW; ++i) {
                if (!valid[i]) continue;
                const int n = 16 * (nt0 + i) + fr, t1 = n / NB, b = n % NB, s1 = t1 - d1; const bool ok = (unsigned)s1 < (unsigned)NT1;
                const LAS u16* zp = Zs + b * ZLD + 64 * (ok ? s1 : 0) + 8 * fq;
#pragma unroll
                for (int kt = 0; kt < 2; ++kt) {
                    bf16x8 bf = *(const LAS bf16x8*)(zp + 32 * kt);
                    if (!ok) bf = (bf16x8){0, 0, 0, 0, 0, 0, 0, 0};
#pragma unroll
                    for (int m = 0; m < MTW; ++m) acc[i][m] = MFMA(af[m + 2 - 2 * kt], bf, acc[i][m]);
                }
            }
        }
        }
        __syncthreads();
        { const float hb = p.in[I_HBIAS][(e * 2 + o) * 512 + c];
#pragma unroll
          for (int i = 0; i < NTW; ++i) { const int n = 16 * (nt0 + i) + fr, t1 = n / NB, b = n % NB;
#pragma unroll
              for (int m = 0; m < MTW; ++m) { const int tt = 64 * t1 + 16 * (mt0 + m) + 4 * fq;
                  const u32x2 zo = *(const LAS u32x2*)(Zs + b * ZLD + tt), xo = *(const LAS u32x2*)(Xs + b * ZLD + tt);
                  const float z0 = __uint_as_float(zo.x << 16), z1 = __uint_as_float(zo.x & 0xffff0000u), z2 = __uint_as_float(zo.y << 16), z3 = __uint_as_float(zo.y & 0xffff0000u);
                  const float x0 = __uint_as_float(xo.x << 16), x1 = __uint_as_float(xo.x & 0xffff0000u), x2 = __uint_as_float(xo.y << 16), x3 = __uint_as_float(xo.y & 0xffff0000u);
                  const float r0 = x0 * (acc[i][m][0] + z0 * hb), r1 = x1 * (acc[i][m][1] + z1 * hb), r2 = x2 * (acc[i][m][2] + z2 * hb), r3 = x3 * (acc[i][m][3] + z3 * hb);
                  if (o == 0) { u32x2 w; w.x = pk2(r0, r1); w.y = pk2(r2, r3); *(LAS u32x2*)(Zs + b * ZLD + tt) = w; }
                  else { u32x2 w; w.x = pk2(r0, r1); w.y = pk2(r2, r3); *(u32x2*)(yT + (size_t)c * MG + rowbase + b * L + tt) = w; } } } }
        __syncthreads();
    }
}
__device__ __forceinline__ void ph_hytrans(const Params& p, ldsp lds, int g) {
    LAS u16* tile = (LAS u16*)lds;
    const int t = tid_opaque();
    const u16* yT = (const u16*)(p.ws + EV_YT); u16* yg = (u16*)(p.ws + EV_Y) + (size_t)g * MG * 1024;
    for (int it = blockIdx.x; it < 2560; it += gridDim.x) {
        const int r0 = (it >> 3) * 64, c0 = (it & 7) * 64;
        __syncthreads();
        { const int c = t >> 3, r8 = (t & 7) * 8; *(LAS u32x4*)(tile + c * 72 + r8) = *(const u32x4*)(yT + (size_t)(c0 + c) * MG + r0 + r8); }
        __syncthreads();
        { const int r = t >> 3, c8 = (t & 7) * 8; u32x4 w;
          w.x = (unsigned)tile[(c8 + 0) * 72 + r] | ((unsigned)tile[(c8 + 1) * 72 + r] << 16); w.y = (unsigned)tile[(c8 + 2) * 72 + r] | ((unsigned)tile[(c8 + 3) * 72 + r] << 16);
          w.z = (unsigned)tile[(c8 + 4) * 72 + r] | ((unsigned)tile[(c8 + 5) * 72 + r] << 16); w.w = (unsigned)tile[(c8 + 6) * 72 + r] | ((unsigned)tile[(c8 + 7) * 72 + r] << 16);
          *(u32x4*)(yg + (size_t)(r0 + r) * 1024 + c0 + c8) = w; }
    }
}
__device__ __forceinline__ void ph_hyena(const Params& p, ldsp lds, int e) {
    for (int it = blockIdx.x; it < 1024; it += gridDim.x) {
        if (it < 512) hyena_item<4096, 4, 2, 4>(p, lds, e, it, CTXG); else hyena_item<256, 16, 1, 2>(p, lds, e, it - 512, 0);
    }
}

typedef short s16x4 __attribute__((ext_vector_type(4)));
__device__ __forceinline__ bf16x8 ld_tr(const LAS u16* base, int ld, int rowA, int rowB, int col0, int lane) {
    const int q = (lane & 15) >> 2, pp = lane & 3;
    const s16x4 v0 = __builtin_amdgcn_ds_read_tr16_b64_v4i16((LAS s16x4*)(base + (rowA + q) * ld + col0 + 4 * pp));
    const s16x4 v1 = __builtin_amdgcn_ds_read_tr16_b64_v4i16((LAS s16x4*)(base + (rowB + q) * ld + col0 + 4 * pp));
    return (bf16x8){v0[0], v0[1], v0[2], v0[3], v1[0], v1[1], v1[2], v1[3]};
}
__device__ __forceinline__ float wave_cumsum(float v, int lane) {
#pragma unroll
    for (int o = 1; o < 64; o <<= 1) { const float u = __shfl_up(v, o); if (lane >= o) v += u; } return v; }
__device__ __forceinline__ float wave_cummax(float v, int lane) {
#pragma unroll
    for (int o = 1; o < 64; o <<= 1) { const float u = __shfl_up(v, o); if (lane >= o) v = fmaxf(v, u); } return v; }
__device__ __forceinline__ float wave_max(float v) {
#pragma unroll
    for (int o = 32; o > 0; o >>= 1) v = fmaxf(v, __shfl_xor(v, o)); return v; }

__device__ __forceinline__ void ph_mlact(const Params& p, int e) {
    const u16* projR = (const u16*)(p.ws + EV_PROJR); u16* qk = (u16*)(p.ws + EV_H);
    const float* cw = p.in[I_EVCW] + (size_t)e * 3 * 2560 + 1536; const float* cbias = p.in[I_EVCB] + e * 2560 + 1536;
    const int t = tid_opaque(), c8 = (t & 127) * 8, rg = t >> 7;
    float w0[8], w1[8], w2[8], bb[8]; ld8f(cw + c8, w0); ld8f(cw + 2560 + c8, w1); ld8f(cw + 5120 + c8, w2); ld8f(cbias + c8, bb);
    const float scl = c8 >= 512 ? 0.08838834764831845f : 1.0f;
    for (int r0 = (blockIdx.x * 4 + rg) * 8; r0 < MG; r0 += gridDim.x * 32) {
        const int pos0 = r0 < CTXG ? (r0 & 255) : ((r0 - CTXG) & 4095), L = r0 < CTXG ? 256 : 4096;
        u32x4 rr[10];
#pragma unroll
        for (int i = 0; i < 10; ++i) { const bool ok = (i > 0 || pos0 > 0) && (i < 9 || pos0 + 8 < L); rr[i] = ok ? *(const u32x4*)(projR + (size_t)(r0 - 1 + i) * EVR + c8) : (u32x4){0u, 0u, 0u, 0u}; }
#pragma unroll
        for (int i = 0; i < 8; ++i) { float pm[8], p0[8], pp[8]; unpack8(rr[i], pm); unpack8(rr[i + 1], p0); unpack8(rr[i + 2], pp);
            float o8[8];
#pragma unroll
            for (int j = 0; j < 8; ++j) o8[j] = siluf(bb[j] + w0[j] * pm[j] + w1[j] * p0[j] + w2[j] * pp[j]) * scl;
            u32x4 w; w.x = pk2(o8[0], o8[1]); w.y = pk2(o8[2], o8[3]); w.z = pk2(o8[4], o8[5]); w.w = pk2(o8[6], o8[7]);
            *(u32x4*)(qk + (size_t)(r0 + i) * 1024 + c8) = w; }
    }
}
__device__ __forceinline__ void ph_mlA(const Params& p, ldsp lds, int e) {
    LAS u16* Ks = (LAS u16*)lds; LAS u16* Vs = Ks + 64 * 144; LAS float* wS = (LAS float*)(Vs + 64 * 144);
    const int t = tid_opaque(), wid = __builtin_amdgcn_readfirstlane(t >> 6), lane = t & 63, fr = lane & 15, fq = lane >> 4;
    const u16* projR = (const u16*)(p.ws + EV_PROJR); const u16* qk = (const u16*)(p.ws + EV_H);
    u16* CT = (u16*)(p.ws + EV_ST); float* nst = (float*)(p.ws + WS_NST); float* sc = (float*)(p.ws + WS_SC);
    const float* gb = p.in[I_MGB] + e * 16;
    for (int it = blockIdx.x; it < 2560; it += gridDim.x) {
        int chi, j, L, seqrow0, sig;
        if (it < 512) { chi = it >> 2; j = it & 3; L = 256; sig = chi >> 3; seqrow0 = sig * 256; }
        else { const int i2 = it - 512; chi = i2 >> 6; j = i2 & 63; L = 4096; sig = chi >> 3; seqrow0 = CTXG + sig * 4096; }
        const int head = (chi >> 1) & 3, dir = chi & 1;
        u32x4 rk[2], rv[2];
#pragma unroll
        for (int q = 0; q < 2; ++q) { const int v = t + q * 512, l = v >> 4, dg = (v & 15) * 8; const int pos = dir ? L - 1 - (64 * j + l) : 64 * j + l;
            rk[q] = *(const u32x4*)(qk + (size_t)(seqrow0 + pos) * 1024 + 512 + head * 128 + dg); rv[q] = *(const u32x4*)(projR + (size_t)(seqrow0 + pos) * EVR + 1024 + head * 128 + dg); }
        u16 gri, grf;
        { const int pos = dir ? L - 1 - (64 * j + lane) : 64 * j + lane; const u16* pr = projR + (size_t)(seqrow0 + pos) * EVR + (3584 - 1536); gri = pr[(dir * 2 + 0) * 4 + head]; grf = pr[(dir * 2 + 1) * 4 + head]; }
        __syncthreads();
        if (wid == 0) {
            const float gi = bf2f(gri) + gb[(dir * 2 + 0) * 4 + head];
            const float lf = logsigf(bf2f(grf) + gb[(dir * 2 + 1) * 4 + head]);
            const float b = wave_cumsum(lf, lane); const float b63 = __shfl(b, 63); const float uu = gi - b; const float gmax = wave_max(uu);
            wS[lane] = __expf(uu - gmax);
            if (lane == 0) { sc[it * 4 + 0] = b63; sc[it * 4 + 1] = b63 + gmax; }
        }
        __syncthreads();
#pragma unroll
        for (int q = 0; q < 2; ++q) { const int v = t + q * 512, l = v >> 4, dg = (v & 15) * 8;
            float kv[8]; unpack8(rk[q], kv); const float wl = wS[l];
            u32x4 w; w.x = pk2(kv[0] * wl, kv[1] * wl); w.y = pk2(kv[2] * wl, kv[3] * wl); w.z = pk2(kv[4] * wl, kv[5] * wl); w.w = pk2(kv[6] * wl, kv[7] * wl);
            *(LAS u32x4*)(Ks + l * 144 + dg) = w; *(LAS u32x4*)(Vs + l * 144 + dg) = rv[q]; }
        __syncthreads();
        {
            f32x4 acc[8];
#pragma unroll
            for (int n = 0; n < 8; ++n) acc[n] = (f32x4){0.f, 0.f, 0.f, 0.f};
#pragma unroll
            for (int kt = 0; kt < 2; ++kt) { const bf16x8 a = ld_tr(Ks, 144, 32 * kt + 8 * fq, 32 * kt + 8 * fq + 4, 16 * wid, lane);
#pragma unroll
                for (int n = 0; n < 8; ++n) acc[n] = MFMA(a, ld_tr(Vs, 144, 32 * kt + 8 * fq, 32 * kt + 8 * fq + 4, 16 * n, lane), acc[n]); }
            u16* cp = CT + (size_t)it * 16384;
#pragma unroll
            for (int n = 0; n < 8; ++n) { u32x2 w; w.x = pk2(acc[n][0], acc[n][1]); w.y = pk2(acc[n][2], acc[n][3]); *(u32x2*)(cp + (16 * n + fr) * 128 + 16 * wid + 4 * fq) = w; }
        }
        if (t < 128) { float sm = 0.f; for (int l = 0; l < 64; ++l) sm += bf2f(Ks[l * 144 + t]); nst[it * 128 + t] = sm; }
    }
}
template <int NC, bool ISCTX>
__device__ __forceinline__ void mlB_part(const Params& p, int e, int g) {
    unsigned* CT = (unsigned*)(p.ws + EV_ST); float* nst = (float*)(p.ws + WS_NST); const float* sc = (const float*)(p.ws + WS_SC); float* msc = (float*)(p.ws + WS_MSC);
    const int nch = ISCTX ? 128 : 32, total = nch * 8320;
    for (int idx = blockIdx.x * NTHREADS + tid_opaque(); idx < total; idx += gridDim.x * NTHREADS) {
        const int chi = idx / 8320, el = idx % 8320; const int sig = chi >> 3, head = (chi >> 1) & 3, dir = chi & 1;
        const int itembase = ISCTX ? chi * 4 : 512 + chi * 64;
        const bool isn = el >= 8192; const int ee = el >> 6, d = (el & 63) * 2;
        float C0 = 0.f, C1 = 0.f, m = 0.f, mrec = 0.f;
        if (!ISCTX) { const int b = g * 4 + sig; const size_t sb = (size_t)((b * 2 + e) * 2 + dir) * 4 + head;
            m = p.in[I_SM][sb];
            if (isn) C0 = p.in[I_SN][sb * 128 + (el - 8192)]; else { C0 = p.in[I_SC][(sb * 128 + d) * 128 + ee]; C1 = p.in[I_SC][(sb * 128 + d + 1) * 128 + ee]; } }
        constexpr int JB = NC < 16 ? NC : 16;
#pragma unroll 1
        for (int j0 = 0; j0 < NC; j0 += JB) {
            unsigned Lu[JB]; float Lf[JB];
#pragma unroll
            for (int j = 0; j < JB; ++j) { if (isn) Lf[j] = nst[(itembase + j0 + j) * 128 + (el - 8192)]; else Lu[j] = CT[(size_t)(itembase + j0 + j) * 8192 + el]; }
#pragma unroll
            for (int j = 0; j < JB; ++j) {
                const float a = sc[(itembase + j0 + j) * 4 + 0], gl = sc[(itembase + j0 + j) * 4 + 1];
                if (el == j0 + j) mrec = m;
                const float mn = fmaxf(a + m, gl); const float fa = __expf(a + m - mn), fb = __expf(gl - mn);
                if (isn) { const float t0 = Lf[j]; Lf[j] = C0; C0 = fa * C0 + fb * t0; }
                else { const float t0 = __uint_as_float(Lu[j] << 16), t1 = __uint_as_float(Lu[j] & 0xffff0000u); Lu[j] = pk2(C0, C1); C0 = fa * C0 + fb * t0; C1 = fa * C1 + fb * t1; }
                m = mn;
            }
#pragma unroll
            for (int j = 0; j < JB; ++j) { if (isn) nst[(itembase + j0 + j) * 128 + (el - 8192)] = Lf[j]; else CT[(size_t)(itembase + j0 + j) * 8192 + el] = Lu[j]; }
        }
        if (el < NC) msc[itembase + el] = mrec;
        if (ISCTX) { const int b = g * 16 + sig; const size_t sb = (size_t)((b * 2 + e) * 2 + dir) * 4 + head;
            if (isn) p.out[OUT_N + sb * 128 + (el - 8192)] = C0; else { p.out[OUT_C + (sb * 128 + d) * 128 + ee] = C0; p.out[OUT_C + (sb * 128 + d + 1) * 128 + ee] = C1; }
            if (el == 0) p.out[OUT_M + sb] = m; }
    }
}
__device__ __forceinline__ void ph_mlB(const Params& p, int e, int g) { mlB_part<64, false>(p, e, g); mlB_part<4, true>(p, e, g); }
__device__ __forceinline__ void ph_mlC(const Params& p, ldsp lds, int e, int g) {
    LAS u16* qs = (LAS u16*)lds; LAS u16* ks = qs + 64 * 136; LAS u16* Vs = ks + 64 * 136; LAS u16* CTs = Vs + 64 * 144; LAS u16* Sb = CTs + 144 * 136;
    LAS float* hbuf = (LAS float*)(Sb + 64 * 72); LAS float* rt = hbuf + 64 * 128; LAS float* uu = rt + 64; LAS float* ain = uu + 64; LAS float* emt = ain + 64; LAS float* den = emt + 64;
    const int t = tid_opaque(), wid = __builtin_amdgcn_readfirstlane(t >> 6), lane = t & 63, fr = lane & 15, fq = lane >> 4;
    const u16* projR = (const u16*)(p.ws + EV_PROJR); const u16* qk = (const u16*)(p.ws + EV_H);
    const u16* CT = (const u16*)(p.ws + EV_ST); const float* nst = (const float*)(p.ws + WS_NST); const float* msc = (const float*)(p.ws + WS_MSC);
    u16* yg = (u16*)(p.ws + EV_Y) + (size_t)g * MG * 1024;
    const float* gb = p.in[I_MGB] + e * 16;
    for (int it = blockIdx.x; it < 1280; it += gridDim.x) {
        int sig, head, jo, L, NC, seqrow0, cbase; bool isctx = it >= 1024;
        if (isctx) { const int i2 = it - 1024; sig = i2 >> 4; head = (i2 >> 2) & 3; jo = i2 & 3; L = 256; NC = 4; seqrow0 = sig * 256; }
        else { sig = it >> 8; head = (it >> 6) & 3; jo = it & 63; L = 4096; NC = 64; seqrow0 = CTXG + sig * 4096; }
        cbase = (sig * 4 + head) * 2;
#pragma unroll 1
        for (int dir = 0; dir < 2; ++dir) {
            const int jd = dir ? NC - 1 - jo : jo; const int chi = cbase + dir; const int item = (isctx ? chi * 4 : 512 + chi * 64) + jd;
            const float mst = msc[item];
            u32x4 rq[2], rk[2], rv[2], rc[4];
#pragma unroll
            for (int q = 0; q < 2; ++q) { const int v = t + q * 512, l = v >> 4, dg = (v & 15) * 8; const int pos = dir ? L - 1 - (64 * jd + l) : 64 * jd + l;
                const u16* qp = qk + (size_t)(seqrow0 + pos) * 1024 + head * 128 + dg; rq[q] = *(const u32x4*)qp; rk[q] = *(const u32x4*)(qp + 512);
                rv[q] = *(const u32x4*)(projR + (size_t)(seqrow0 + pos) * EVR + 1024 + head * 128 + dg); }
#pragma unroll
            for (int q = 0; q < 4; ++q) { const int v = t + q * 512; rc[q] = *(const u32x4*)(CT + (size_t)item * 16384 + v * 8); }
            u16 gri, grf;
            { const int pos = dir ? L - 1 - (64 * jd + lane) : 64 * jd + lane; const u16* pr = projR + (size_t)(seqrow0 + pos) * EVR + (3584 - 1536); gri = pr[(dir * 2 + 0) * 4 + head]; grf = pr[(dir * 2 + 1) * 4 + head]; }
            const float nval = nst[item * 128 + (t & 127)];
            __syncthreads();
            if (wid == 0) {
                const float gi = bf2f(gri) + gb[(dir * 2 + 0) * 4 + head];
                const float lf = logsigf(bf2f(grf) + gb[(dir * 2 + 1) * 4 + head]);
                const float b = wave_cumsum(lf, lane); const float u_ = gi - b; const float pm = wave_cummax(u_, lane); const float mt = b + fmaxf(mst, pm);
                rt[lane] = b - mt; uu[lane] = u_; ain[lane] = __expf(b + mst - mt); emt[lane] = __expf(-mt);
            }
#pragma unroll
            for (int q = 0; q < 2; ++q) { const int v = t + q * 512, l = v >> 4, dg = (v & 15) * 8;
                *(LAS u32x4*)(qs + l * 136 + dg) = rq[q]; *(LAS u32x4*)(ks + l * 136 + dg) = rk[q]; *(LAS u32x4*)(Vs + l * 144 + dg) = rv[q]; }
            if (t < 128) { const int l = t >> 1, hf = t & 1; u32x4 w; w.x = hf ? 0u : 0x3F80u; w.y = 0u; w.z = 0u; w.w = 0u; *(LAS u32x4*)(Vs + l * 144 + 128 + hf * 8) = w; }
#pragma unroll
            for (int q = 0; q < 4; ++q) { const int v = t + q * 512, ee = v >> 4, dg = (v & 15) * 8; *(LAS u32x4*)(CTs + ee * 136 + dg) = rc[q]; }
            for (int idx = t; idx < 16 * 128; idx += NTHREADS) { const int r = idx >> 7, d = idx & 127; CTs[(128 + r) * 136 + d] = r == 0 ? f2bf(nval) : (u16)0; }
            __syncthreads();
            {
                const int mt_ = wid >> 1;
                f32x4 a2[2] = {(f32x4){0.f, 0.f, 0.f, 0.f}, (f32x4){0.f, 0.f, 0.f, 0.f}};
#pragma unroll
                for (int kt = 0; kt < 4; ++kt) { const bf16x8 a = ldfrag(qs, (16 * mt_ + fr) * 136 + kt * 32 + fq * 8);
#pragma unroll
                    for (int i = 0; i < 2; ++i) { const int nt = (wid & 1) * 2 + i; const bf16x8 b = ldfrag(ks, (16 * nt + fr) * 136 + kt * 32 + fq * 8); a2[i] = MFMA(a, b, a2[i]); } }
#pragma unroll
                for (int i = 0; i < 2; ++i) { const int s_ = 16 * ((wid & 1) * 2 + i) + fr; const float us = uu[s_];
#pragma unroll
                    for (int jj = 0; jj < 4; ++jj) { const int l = 16 * mt_ + 4 * fq + jj; const float w = s_ <= l ? __expf(rt[l] + us) : 0.f; Sb[l * 72 + s_] = f2bf(a2[i][jj] * w); } }
            }
            __syncthreads();
            f32x4 a1[4], a2[4], d1 = (f32x4){0.f, 0.f, 0.f, 0.f}, d2 = d1;
            { const bf16x8 v0 = ld_tr(Vs, 144, 8 * fq, 8 * fq + 4, 16 * wid, lane), v1 = ld_tr(Vs, 144, 32 + 8 * fq, 32 + 8 * fq + 4, 16 * wid, lane);
#pragma unroll
              for (int mt_ = 0; mt_ < 4; ++mt_) { a1[mt_] = (f32x4){0.f, 0.f, 0.f, 0.f}; a2[mt_] = a1[mt_];
                a1[mt_] = MFMA(ldfrag(Sb, (16 * mt_ + fr) * 72 + fq * 8), v0, a1[mt_]); a1[mt_] = MFMA(ldfrag(Sb, (16 * mt_ + fr) * 72 + 32 + fq * 8), v1, a1[mt_]);
#pragma unroll
                for (int kt = 0; kt < 4; ++kt) a2[mt_] = MFMA(ldfrag(qs, (16 * mt_ + fr) * 136 + kt * 32 + fq * 8), ldfrag(CTs, (16 * wid + fr) * 136 + kt * 32 + fq * 8), a2[mt_]); } }
            {
                const int mtw = wid & 3;
                const bf16x8 v0 = ld_tr(Vs, 144, 8 * fq, 8 * fq + 4, 128, lane), v1 = ld_tr(Vs, 144, 32 + 8 * fq, 32 + 8 * fq + 4, 128, lane);
                d1 = MFMA(ldfrag(Sb, (16 * mtw + fr) * 72 + fq * 8), v0, d1); d1 = MFMA(ldfrag(Sb, (16 * mtw + fr) * 72 + 32 + fq * 8), v1, d1);
#pragma unroll
                for (int kt = 0; kt < 4; ++kt) d2 = MFMA(ldfrag(qs, (16 * mtw + fr) * 136 + kt * 32 + fq * 8), ldfrag(CTs, (128 + fr) * 136 + kt * 32 + fq * 8), d2);
                if (wid < 4 && fr == 0) {
#pragma unroll
                    for (int jj = 0; jj < 4; ++jj) { const int l = 16 * mtw + 4 * fq + jj; den[l] = d1[jj] + ain[l] * d2[jj]; } }
            }
            __syncthreads();
#pragma unroll
            for (int mt_ = 0; mt_ < 4; ++mt_)
#pragma unroll
                for (int jj = 0; jj < 4; ++jj) { const int l = 16 * mt_ + 4 * fq + jj, ee = 16 * wid + fr;
                    const float h = (a1[mt_][jj] + ain[l] * a2[mt_][jj]) * __builtin_amdgcn_rcpf(fmaxf(fabsf(den[l]), emt[l]));
                    if (dir == 0) hbuf[l * 128 + ee] = h; else hbuf[(63 - l) * 128 + ee] += h; }
        }
        __syncthreads();
        { const int row = t >> 3, seg = t & 7; const int grow = seqrow0 + 64 * jo + row;
          float v[16], ss = 0.f;
#pragma unroll
          for (int i = 0; i < 16; ++i) { v[i] = hbuf[row * 128 + seg * 16 + i]; ss += v[i] * v[i]; }
          ss += __shfl_xor(ss, 1); ss += __shfl_xor(ss, 2); ss += __shfl_xor(ss, 4);
          const float rstd = rsqrtf(ss * (1.0f / 128.0f) + EPS);
          const u16* op = projR + (size_t)grow * EVR + (3072 - 1536) + head * 128 + seg * 16; const float* ng = p.in[I_MNG] + e * 512 + head * 128 + seg * 16;
          float o0[8], o1[8]; ld8(op, o0); ld8(op + 8, o1);
          u32x4 w0, w1;
          w0.x = pk2(v[0] * rstd * ng[0] * sigmf(o0[0]), v[1] * rstd * ng[1] * sigmf(o0[1])); w0.y = pk2(v[2] * rstd * ng[2] * sigmf(o0[2]), v[3] * rstd * ng[3] * sigmf(o0[3]));
          w0.z = pk2(v[4] * rstd * ng[4] * sigmf(o0[4]), v[5] * rstd * ng[5] * sigmf(o0[5])); w0.w = pk2(v[6] * rstd * ng[6] * sigmf(o0[6]), v[7] * rstd * ng[7] * sigmf(o0[7]));
          w1.x = pk2(v[8] * rstd * ng[8] * sigmf(o1[0]), v[9] * rstd * ng[9] * sigmf(o1[1])); w1.y = pk2(v[10] * rstd * ng[10] * sigmf(o1[2]), v[11] * rstd * ng[11] * sigmf(o1[3]));
          w1.z = pk2(v[12] * rstd * ng[12] * sigmf(o1[4]), v[13] * rstd * ng[13] * sigmf(o1[5])); w1.w = pk2(v[14] * rstd * ng[14] * sigmf(o1[6]), v[15] * rstd * ng[15] * sigmf(o1[7]));
          u16* yp = yg + (size_t)grow * 1024 + 512 + head * 128 + seg * 16; *(u32x4*)yp = w0; *(u32x4*)(yp + 8) = w1; }
    }
}

__device__ __forceinline__ bf16x8 ld_perm(const LAS u16* rowp, int kt, int fq) {
    const u32x2 a = *(const LAS u32x2*)(rowp + 32 * kt + 4 * fq), b = *(const LAS u32x2*)(rowp + 32 * kt + 16 + 4 * fq);
    u32x4 v; v.x = a.x; v.y = a.y; v.z = b.x; v.w = b.y; return __builtin_bit_cast(bf16x8, v); }
__device__ __forceinline__ bf16x8 pack_acc(f32x4 a, f32x4 b) { u32x4 v; v.x = pk2(a[0], a[1]); v.y = pk2(a[2], a[3]); v.z = pk2(b[0], b[1]); v.w = pk2(b[2], b[3]); return __builtin_bit_cast(bf16x8, v); }
__device__ __forceinline__ void ph_ssdact(const Params& p, int o) {
    const u16* raw = (const u16*)(p.ws + OD_RAW); u16* act = (u16*)(p.ws + OD_ACT);
    const float* cw = p.in[I_ODCW] + (size_t)o * 3 * 4096; const float* cbias = p.in[I_ODCB] + o * 4096;
    const int t = tid_opaque(), c8 = (t & 511) * 8;
    float w0[8], w1[8], w2[8], bb[8]; ld8f(cw + c8, w0); ld8f(cw + 4096 + c8, w1); ld8f(cw + 8192 + c8, w2); ld8f(cbias + c8, bb);
    for (int r0 = blockIdx.x * 8; r0 < MG; r0 += gridDim.x * 8) {
        const int pos0 = r0 < CTXG ? (r0 & 255) : ((r0 - CTXG) & 4095), L = r0 < CTXG ? 256 : 4096;
        u32x4 rr[10];
#pragma unroll
        for (int i = 0; i < 10; ++i) { const bool ok = (i > 0 || pos0 > 0) && (i < 9 || pos0 + 8 < L); rr[i] = ok ? *(const u32x4*)(raw + (size_t)(r0 - 1 + i) * 4096 + c8) : (u32x4){0u, 0u, 0u, 0u}; }
#pragma unroll
        for (int i = 0; i < 8; ++i) { float pm[8], p0[8], pp[8]; unpack8(rr[i], pm); unpack8(rr[i + 1], p0); unpack8(rr[i + 2], pp);
            float o8[8];
#pragma unroll
            for (int j = 0; j < 8; ++j) o8[j] = siluf(bb[j] + w0[j] * pm[j] + w1[j] * p0[j] + w2[j] * pp[j]);
            u32x4 w; w.x = pk2(o8[0], o8[1]); w.y = pk2(o8[2], o8[3]); w.z = pk2(o8[4], o8[5]); w.w = pk2(o8[6], o8[7]);
            *(u32x4*)(act + (size_t)(r0 + i) * 4096 + c8) = w; }
    }
}
template <bool PASSB>
__device__ __forceinline__ void ssd_pass(const Params& p, ldsp lds, int o, int g) {
    LAS u16* Cm = (LAS u16*)lds; LAS u16* Bm = Cm + 64 * 144; LAS u16* X = Bm + 64 * 144; LAS u16* X2 = X + 64 * 272;
    LAS float* cbL = (LAS float*)(X2 + 64 * 272); LAS float* acsb = cbL + 64 * 68; LAS float* dtsb = acsb + 512;
    const int t = tid_opaque(), wid = __builtin_amdgcn_readfirstlane(t >> 6), lane = t & 63, fr = lane & 15, fq = lane >> 4;
    const int hh = wid >> 1, pt0 = 2 * (wid & 1);
    const u16* act = (const u16*)(p.ws + OD_ACT); const u16* zd = (const u16*)(p.ws + OD_ZD);
    u16* segbuf = (u16*)(p.ws + OD_SEG); float* dseg = (float*)(p.ws + OD_DSEG);
    const int nitems = PASSB ? 768 : 448;
    for (int it = blockIdx.x; it < nitems; it += gridDim.x) {
        int sig, grp, dir, seg, L, nsteps, seqrow0; bool islat = true;
        if (PASSB) {
            islat = it < 512;
            if (islat) { seg = it & 7; dir = (it >> 3) & 1; grp = (it >> 4) & 7; sig = it >> 7; L = 4096; nsteps = 8; seqrow0 = CTXG + sig * 4096; }
            else { const int i2 = it - 512; seg = 0; dir = i2 & 1; grp = (i2 >> 1) & 7; sig = i2 >> 4; L = 256; nsteps = 4; seqrow0 = sig * 256; }
        } else { seg = it % 7; const int r = it / 7; dir = r & 1; grp = (r >> 1) & 7; sig = r >> 4; L = 4096; nsteps = 8; seqrow0 = CTXG + sig * 4096; }
        const int head = grp * 4 + hh, chain = (sig * 8 + grp) * 2 + dir, jd0 = seg * 8;
        u16* ydir = (u16*)(p.ws + (dir ? OD_YB : OD_YF));
        f32x4 ST[2][8];
        {
            const float* sp = nullptr; const u16* sp16 = nullptr;
            if (PASSB && islat) { if (seg == 0) sp = p.in[I_SSD] + ((size_t)(((g * 4 + sig) * 2 + o) * 2 + dir) * 32 + head) * 8192; else sp16 = segbuf + ((size_t)(chain * 7 + seg - 1) * 4 + hh) * 8192; }
#pragma unroll
            for (int pi = 0; pi < 2; ++pi)
#pragma unroll
                for (int n = 0; n < 8; ++n) { const int off = (16 * (pt0 + pi) + fr) * 128 + 16 * n + 4 * fq;
                    if (sp16) { const u32x2 w = *(const u32x2*)(sp16 + off); ST[pi][n] = (f32x4){__uint_as_float(w.x << 16), __uint_as_float(w.x & 0xffff0000u), __uint_as_float(w.y << 16), __uint_as_float(w.y & 0xffff0000u)}; }
                    else ST[pi][n] = sp ? *(const f32x4*)(sp + off) : (f32x4){0.f, 0.f, 0.f, 0.f}; }
        }
        float Aneg = 0.f, dtb = 0.f, dsum = 0.f;
        if (wid < 4) { const int hd = grp * 4 + wid; Aneg = -__expf(p.in[I_ALOG][(o * 2 + dir) * 32 + hd]); dtb = p.in[I_DTB][(o * 2 + dir) * 32 + hd]; }
        __syncthreads();
        float dtp_n = 0.f;
        if (wid < 4) { const int pos = dir ? L - 1 - (64 * jd0 + lane) : 64 * jd0 + lane;
            const float dt = softplusf(bf2f(zd[(size_t)(seqrow0 + pos) * ZDL + 2048 + dir * 32 + grp * 4 + wid]) + dtb); const float ac = wave_cumsum(dt * Aneg, lane);
            dtsb[wid * 64 + lane] = dt; acsb[wid * 64 + lane] = ac; dsum += __shfl(ac, 63);
            const int pos1 = dir ? L - 1 - (64 * (jd0 + 1) + lane) : 64 * (jd0 + 1) + lane; dtp_n = bf2f(zd[(size_t)(seqrow0 + pos1) * ZDL + 2048 + dir * 32 + grp * 4 + wid]); }
        __syncthreads();
        u32x4 rb[2], rx[4];
#pragma unroll
        for (int q = 0; q < 2; ++q) { const int v = t + q * 512, l = v >> 4, ng = (v & 15) * 8; const int pos = dir ? L - 1 - (64 * jd0 + l) : 64 * jd0 + l;
            const u16* rowp = act + (size_t)(seqrow0 + pos) * 4096; rb[q] = *(const u32x4*)(rowp + 2048 + grp * 128 + ng); }
#pragma unroll
        for (int q = 0; q < 4; ++q) { const int v = t + q * 512, l = v >> 5, cg_ = (v & 31) * 8; const int pos = dir ? L - 1 - (64 * jd0 + l) : 64 * jd0 + l;
            rx[q] = *(const u32x4*)(act + (size_t)(seqrow0 + pos) * 4096 + grp * 256 + cg_); }
#pragma unroll 1
        for (int st = 0; st < nsteps; ++st) {
            const int jd = jd0 + st, cur = st & 1;
            {
                u32x4 rc[2];
                if (PASSB) {
#pragma unroll
                    for (int q = 0; q < 2; ++q) { const int v = t + q * 512, l = v >> 4, ng = (v & 15) * 8; const int pos = dir ? L - 1 - (64 * jd + l) : 64 * jd + l;
                        rc[q] = *(const u32x4*)(act + (size_t)(seqrow0 + pos) * 4096 + 3072 + grp * 128 + ng); } }
#pragma unroll
                for (int q = 0; q < 2; ++q) { const int v = t + q * 512, l = v >> 4, ng = (v & 15) * 8; *(LAS u32x4*)(Bm + l * 144 + ng) = rb[q]; }
#pragma unroll
                for (int q = 0; q < 4; ++q) { const int v = t + q * 512, l = v >> 5, cg_ = (v & 31) * 8, h = cg_ >> 6;
                    float xv[8]; unpack8(rx[q], xv);
                    const float dt = dtsb[(cur * 4 + h) * 64 + l], de = __expf(acsb[(cur * 4 + h) * 64 + 63] - acsb[(cur * 4 + h) * 64 + l]);
#pragma unroll
                    for (int jj = 0; jj < 8; ++jj) xv[jj] *= dt;
                    u32x4 w;
                    if (PASSB) { w.x = pk2(xv[0], xv[1]); w.y = pk2(xv[2], xv[3]); w.z = pk2(xv[4], xv[5]); w.w = pk2(xv[6], xv[7]); *(LAS u32x4*)(X + l * 272 + cg_) = w; }
                    w.x = pk2(xv[0] * de, xv[1] * de); w.y = pk2(xv[2] * de, xv[3] * de); w.z = pk2(xv[4] * de, xv[5] * de); w.w = pk2(xv[6] * de, xv[7] * de); *(LAS u32x4*)(X2 + l * 272 + cg_) = w; }
                if (PASSB) {
#pragma unroll
                    for (int q = 0; q < 2; ++q) { const int v = t + q * 512, l = v >> 4, ng = (v & 15) * 8; *(LAS u32x4*)(Cm + l * 144 + ng) = rc[q]; } }
                if (st + 1 < nsteps) {
#pragma unroll
                    for (int q = 0; q < 2; ++q) { const int v = t + q * 512, l = v >> 4, ng = (v & 15) * 8; const int pos = dir ? L - 1 - (64 * (jd + 1) + l) : 64 * (jd + 1) + l;
                        const u16* rowp = act + (size_t)(seqrow0 + pos) * 4096; rb[q] = *(const u32x4*)(rowp + 2048 + grp * 128 + ng); }
#pragma unroll
                    for (int q = 0; q < 4; ++q) { const int v = t + q * 512, l = v >> 5, cg_ = (v & 31) * 8; const int pos = dir ? L - 1 - (64 * (jd + 1) + l) : 64 * (jd + 1) + l;
                        rx[q] = *(const u32x4*)(act + (size_t)(seqrow0 + pos) * 4096 + grp * 256 + cg_); }
                }
            }
            if (wid < 4 && st + 1 < nsteps) {
                const float dt = softplusf(dtp_n + dtb); const float ac = wave_cumsum(dt * Aneg, lane);
                dtsb[((cur ^ 1) * 4 + wid) * 64 + lane] = dt; acsb[((cur ^ 1) * 4 + wid) * 64 + lane] = ac; dsum += __shfl(ac, 63);
                if (st + 2 < nsteps) { const int pos2 = dir ? L - 1 - (64 * (jd + 2) + lane) : 64 * (jd + 2) + lane; dtp_n = bf2f(zd[(size_t)(seqrow0 + pos2) * ZDL + 2048 + dir * 32 + grp * 4 + wid]); } }
            __syncthreads();
            const LAS float* ac = acsb + (cur * 4 + hh) * 64;
            if (PASSB) {
#pragma unroll 1
                for (int rep_ = 0; rep_ < ((PROBE & 2048) ? 2 : 1); ++rep_) {
                    const int stile = wid >> 1;
                    f32x4 a2[2] = {(f32x4){0.f, 0.f, 0.f, 0.f}, (f32x4){0.f, 0.f, 0.f, 0.f}};
#pragma unroll
                    for (int kt = 0; kt < 4; ++kt) { const bf16x8 a = ldfrag(Bm, (16 * stile + fr) * 144 + kt * 32 + fq * 8);
#pragma unroll
                        for (int i = 0; i < 2; ++i) a2[i] = MFMA(a, ldfrag(Cm, (16 * (2 * (wid & 1) + i) + fr) * 144 + kt * 32 + fq * 8), a2[i]); }
#pragma unroll
                    for (int i = 0; i < 2; ++i) *(LAS f32x4*)(cbL + (16 * (2 * (wid & 1) + i) + fr) * 68 + 16 * stile + 4 * fq) = a2[i];
                }
                __syncthreads();
                auto ltbody = [&](const int lt, auto k1tag) {
                    constexpr bool K1 = decltype(k1tag)::value;
                    const int l = 16 * lt + fr; const float acl = ac[l];
                    asm volatile("" : "+v"(ST[0][0]), "+v"(ST[0][1]), "+v"(ST[0][2]), "+v"(ST[0][3]), "+v"(ST[0][4]), "+v"(ST[0][5]), "+v"(ST[0][6]), "+v"(ST[0][7]));
                    asm volatile("" : "+v"(ST[1][0]), "+v"(ST[1][1]), "+v"(ST[1][2]), "+v"(ST[1][3]), "+v"(ST[1][4]), "+v"(ST[1][5]), "+v"(ST[1][6]), "+v"(ST[1][7]));
                    bf16x8 cm[4], xa[2][2];
#pragma unroll
                    for (int kt = 0; kt < 4; ++kt) cm[kt] = ld_perm(Cm + l * 144, kt, fq);
#pragma unroll
                    for (int pi = 0; pi < 2; ++pi)
#pragma unroll
                        for (int kt = 0; kt < (K1 ? 2 : 1); ++kt) xa[pi][kt] = ld_tr(X, 272, 32 * kt + 4 * fq, 32 * kt + 16 + 4 * fq, 64 * hh + 16 * (pt0 + pi), lane);
                    bf16x8 pf[2];
#pragma unroll
                    for (int kt = 0; kt < (K1 ? 2 : 1); ++kt) { const int sA = 32 * kt + 4 * fq, sB = sA + 16;
                        const f32x4 ca = *(const LAS f32x4*)(cbL + l * 68 + sA), cb_ = *(const LAS f32x4*)(cbL + l * 68 + sB), aa = *(const LAS f32x4*)(ac + sA), ab = *(const LAS f32x4*)(ac + sB);
                        f32x4 ra, rb_;
#pragma unroll
                        for (int jj = 0; jj < 4; ++jj) { ra[jj] = (sA + jj <= l) ? ca[jj] * __expf(acl - aa[jj]) : 0.f; rb_[jj] = (sB + jj <= l) ? cb_[jj] * __expf(acl - ab[jj]) : 0.f; }
                        pf[kt] = pack_acc(ra, rb_); }
                    const float eacl = __expf(acl);
                    const int pos = dir ? L - 1 - (64 * jd + l) : 64 * jd + l;
                    f32x4 y0 = (f32x4){0.f, 0.f, 0.f, 0.f}, y1 = y0;
#pragma unroll
                    for (int kt = 0; kt < 4; ++kt) { y0 = MFMA(pack_acc(ST[0][2 * kt], ST[0][2 * kt + 1]), cm[kt], y0); y1 = MFMA(pack_acc(ST[1][2 * kt], ST[1][2 * kt + 1]), cm[kt], y1); }
                    y0 = y0 * eacl; y1 = y1 * eacl;
#pragma unroll
                    for (int kt = 0; kt < (K1 ? 2 : 1); ++kt) { y0 = MFMA(xa[0][kt], pf[kt], y0); y1 = MFMA(xa[1][kt], pf[kt], y1); }
                    { u32x2 w; w.x = pk2(y0[0], y0[1]); w.y = pk2(y0[2], y0[3]); *(u32x2*)(ydir + (size_t)(seqrow0 + pos) * 2048 + head * 64 + 16 * pt0 + 4 * fq) = w;
                      w.x = pk2(y1[0], y1[1]); w.y = pk2(y1[2], y1[3]); *(u32x2*)(ydir + (size_t)(seqrow0 + pos) * 2048 + head * 64 + 16 * (pt0 + 1) + 4 * fq) = w; }
                };
#pragma unroll 1
                for (int lt = 0; lt < 2; ++lt) ltbody(lt, std::false_type{});
#pragma unroll 1
                for (int lt = 2; lt < 4; ++lt) ltbody(lt, std::true_type{});
            }
            {
                const float dec = __expf(ac[63]);
#pragma unroll
                for (int pi = 0; pi < 2; ++pi) {
                    __builtin_amdgcn_sched_barrier(0);
                    const bf16x8 b0 = ld_tr(X2, 272, 8 * fq, 8 * fq + 4, 64 * hh + 16 * (pt0 + pi), lane), b1 = ld_tr(X2, 272, 32 + 8 * fq, 32 + 8 * fq + 4, 64 * hh + 16 * (pt0 + pi), lane);
#pragma unroll
                    for (int n = 0; n < 8; ++n) { ST[pi][n] = ST[pi][n] * dec;
                        ST[pi][n] = MFMA(ld_tr(Bm, 144, 8 * fq, 8 * fq + 4, 16 * n, lane), b0, ST[pi][n]); ST[pi][n] = MFMA(ld_tr(Bm, 144, 32 + 8 * fq, 32 + 8 * fq + 4, 16 * n, lane), b1, ST[pi][n]); }
                }
            }
            __syncthreads();
        }
        {
            float* sp = nullptr;
            if (!PASSB) { u16* sp16 = segbuf + ((size_t)(chain * 7 + seg) * 4 + hh) * 8192; if (wid < 4 && lane == 0) dseg[(chain * 7 + seg) * 4 + wid] = dsum;
#pragma unroll
                for (int pi = 0; pi < 2; ++pi)
#pragma unroll
                    for (int n = 0; n < 8; ++n) { u32x2 w; w.x = pk2(ST[pi][n][0], ST[pi][n][1]); w.y = pk2(ST[pi][n][2], ST[pi][n][3]); *(u32x2*)(sp16 + (16 * (pt0 + pi) + fr) * 128 + 16 * n + 4 * fq) = w; } }
            else if (!islat) sp = p.out + OUT_SSD + ((size_t)(((g * 16 + sig) * 2 + o) * 2 + dir) * 32 + head) * 8192;
            if (sp) {
#pragma unroll
                for (int pi = 0; pi < 2; ++pi)
#pragma unroll
                    for (int n = 0; n < 8; ++n) *(f32x4*)(sp + (16 * (pt0 + pi) + fr) * 128 + 16 * n + 4 * fq) = ST[pi][n];
            }
        }
    }
}
__device__ __forceinline__ void ph_ssdA(const Params& p, ldsp lds, int o, int g) { ssd_pass<false>(p, lds, o, g); }
__device__ __forceinline__ void ph_ssdB(const Params& p, ldsp lds, int o, int g) { ssd_pass<true>(p, lds, o, g); }
__device__ __forceinline__ void ph_ssdcomb(const Params& p, int o, int g) {
    unsigned* segbuf = (unsigned*)(p.ws + OD_SEG); const float* dseg = (const float*)(p.ws + OD_DSEG);
    for (int idx = blockIdx.x * NTHREADS + tid_opaque(); idx < 64 * 4 * 4096; idx += gridDim.x * NTHREADS) {
        const int chain = idx >> 14, h = (idx >> 12) & 3, el = idx & 4095; const int sig = chain >> 4, grp = (chain >> 1) & 7, dir = chain & 1;
        const float* s0 = p.in[I_SSD] + ((size_t)(((g * 4 + sig) * 2 + o) * 2 + dir) * 32 + grp * 4 + h) * 8192 + 2 * el;
        float c0 = s0[0], c1 = s0[1];
        unsigned Lv[7]; float dv[7];
#pragma unroll
        for (int sg = 0; sg < 7; ++sg) { const int en = (chain * 7 + sg) * 4 + h; Lv[sg] = segbuf[(size_t)en * 4096 + el]; dv[sg] = dseg[en]; }
#pragma unroll
        for (int sg = 0; sg < 7; ++sg) { const float f = __expf(dv[sg]); c0 = f * c0 + __uint_as_float(Lv[sg] << 16); c1 = f * c1 + __uint_as_float(Lv[sg] & 0xffff0000u); Lv[sg] = pk2(c0, c1); }
#pragma unroll
        for (int sg = 0; sg < 7; ++sg) { const int en = (chain * 7 + sg) * 4 + h; segbuf[(size_t)en * 4096 + el] = Lv[sg]; }
    }
}
__device__ __forceinline__ void ph_ssdfin(const Params& p, int o) {
    const int t = tid_opaque(), wid = __builtin_amdgcn_readfirstlane(t >> 6), lane = t & 63;
    const u16* act = (const u16*)(p.ws + OD_ACT); const u16* zd = (const u16*)(p.ws + OD_ZD); u16* yf = (u16*)(p.ws + OD_YF); const u16* yb = (const u16*)(p.ws + OD_YB);
    const float* ng = p.in[I_SSDNG] + o * 2048; const float* Dh = p.in[I_SSDD] + o * 32;
    for (int r = blockIdx.x * 8 + wid; r < MG; r += gridDim.x * 8) {
        u32x4 ra[4], rb[4], rx[4], rz[4];
#pragma unroll
        for (int i = 0; i < 4; ++i) { const int c0 = i * 512 + lane * 8; ra[i] = *(const u32x4*)(yf + (size_t)r * 2048 + c0); rb[i] = *(const u32x4*)(yb + (size_t)r * 2048 + c0);
            rx[i] = *(const u32x4*)(act + (size_t)r * 4096 + c0); rz[i] = *(const u32x4*)(zd + (size_t)r * ZDL + c0); }
        float yv[4][8]; float ss = 0.f;
#pragma unroll
        for (int i = 0; i < 4; ++i) { const int c0 = i * 512 + lane * 8; float a[8], b[8], x[8], z[8]; unpack8(ra[i], a); unpack8(rb[i], b); unpack8(rx[i], x); unpack8(rz[i], z);
            const float dh = Dh[c0 >> 6];
#pragma unroll
            for (int j = 0; j < 8; ++j) { const float v = (a[j] + b[j] + dh * x[j]) * siluf(z[j]); yv[i][j] = v; ss += v * v; } }
#pragma unroll
        for (int q = 32; q > 0; q >>= 1) ss += __shfl_xor(ss, q);
        const float rstd = rsqrtf(ss * (1.0f / 2048.0f) + EPS);
#pragma unroll
        for (int i = 0; i < 4; ++i) { const int c0 = i * 512 + lane * 8; float gv[8]; ld8f(ng + c0, gv); u32x4 w;
            w.x = pk2(yv[i][0] * rstd * gv[0], yv[i][1] * rstd * gv[1]); w.y = pk2(yv[i][2] * rstd * gv[2], yv[i][3] * rstd * gv[3]);
            w.z = pk2(yv[i][4] * rstd * gv[4], yv[i][5] * rstd * gv[5]); w.w = pk2(yv[i][6] * rstd * gv[6], yv[i][7] * rstd * gv[7]);
            *(u32x4*)(yf + (size_t)r * 2048 + c0) = w; }
    }
}
#define XB_TMO      128
#define XB_XCNT(j)  (256  + 64 * (j))
#define XB_XSUB(j)  (1280 + 64 * (j))
#define XB_XGEN(j)  (2304 + 64 * (j))
#define XB_TOP      3328
#define XB_TOPGEN   3392
#define XCD_BAR_WORDS 3456
#define XB_SPIN_CAP (1u << 24)
__device__ __forceinline__ unsigned xb_ld(unsigned* p)              { return __hip_atomic_load(p, __ATOMIC_RELAXED, __HIP_MEMORY_SCOPE_AGENT); }
__device__ __forceinline__ unsigned xb_add(unsigned* p, unsigned v) { return __hip_atomic_fetch_add(p, v, __ATOMIC_RELAXED, __HIP_MEMORY_SCOPE_AGENT); }
__device__ __forceinline__ unsigned xb_xcc_id() { return (unsigned)__builtin_amdgcn_s_getreg((3 << 11) | 20) & 0xFu; }
#define XB_SPIN(cond, bar) do { unsigned _sp = 0; while (cond) { __builtin_amdgcn_s_sleep(1); \
    if ((++_sp & 255u) == 0u) { if (xb_ld(&(bar)[XB_TMO])) break; if (_sp > XB_SPIN_CAP) { atomicAdd(&(bar)[XB_TMO], 1u); break; } } } } while (0)
struct XcdBarrier { unsigned* bar; unsigned x; volatile LAS unsigned* st; };
__device__ __forceinline__ XcdBarrier xcd_barrier_post(unsigned* bar, volatile LAS unsigned* st) {
    XcdBarrier b; b.bar = bar; b.x = xb_xcc_id(); b.st = st;
    if (threadIdx.x == 0) (void)xb_add(&bar[XB_XCNT(b.x)], 1u);
    return b;
}
__device__ __forceinline__ void xcd_barrier_complete(unsigned* bar, unsigned x, unsigned& nloc, unsigned& nx) {
    const unsigned G = gridDim.x * gridDim.y * gridDim.z;
    unsigned sum, cnt, mine, sp = 0u;
    for (;;) {
        sum = 0u; cnt = 0u; mine = 0u;
#pragma unroll
        for (unsigned j = 0; j < 16; ++j) { const unsigned c = xb_ld(&bar[XB_XCNT(j)]); sum += c; cnt += (c > 0u) ? 1u : 0u; mine = (j == x) ? c : mine; }
        if (sum == G) break;
        __builtin_amdgcn_s_sleep(1);
        if ((++sp & 255u) == 0u) { if (xb_ld(&bar[XB_TMO])) break; if (sp > XB_SPIN_CAP) { atomicAdd(&bar[XB_TMO], 1u); break; } }
    }
    nloc = mine > 0u ? mine : 1u; nx = cnt > 0u ? cnt : 1u;
}
__device__ __forceinline__ void xcd_barrier(const XcdBarrier& b) {
    asm volatile("s_waitcnt vmcnt(0)" ::: "memory");
    __syncthreads();
    if (threadIdx.x == 0) {
        unsigned* bar = b.bar;
        __builtin_amdgcn_s_waitcnt(0);
        unsigned nloc = b.st[0], nx = b.st[1];
        if (nloc == 0u) { xcd_barrier_complete(bar, b.x, nloc, nx); b.st[0] = nloc; b.st[1] = nx; }
        const unsigned old = xb_add(&bar[XB_XSUB(b.x)], 1u);
        const unsigned gen = old / nloc;
        if (old + 1u == (gen + 1u) * nloc) {
            __builtin_amdgcn_fence(__ATOMIC_RELEASE, "agent");
            asm volatile("s_waitcnt vmcnt(0)" ::: "memory");
            const unsigned og = xb_add(&bar[XB_TOP], 1u);
            const unsigned tg = og / nx;
            if (og + 1u == (tg + 1u) * nx) xb_add(&bar[XB_TOPGEN], 1u);
            else XB_SPIN(xb_ld(&bar[XB_TOPGEN]) == tg, bar);
            __builtin_amdgcn_fence(__ATOMIC_ACQUIRE, "agent");
            xb_add(&bar[XB_XGEN(b.x)], 1u);
            asm volatile("s_waitcnt vmcnt(0)" ::: "memory");
        } else {
            XB_SPIN(xb_ld(&bar[XB_XGEN(b.x)]) == gen, bar);
            __builtin_amdgcn_fence(__ATOMIC_ACQUIRE, "agent");
            asm volatile("s_waitcnt vmcnt(0)" ::: "memory");
        }
    }
    __syncthreads();
}
__global__ void __launch_bounds__(NTHREADS, 2) fwd_megakernel(Params p) {
    extern __shared__ __attribute__((aligned(16))) unsigned char shm[];
    ldsp lds = (ldsp)shm;
    cg::grid_group grid = cg::this_grid();
    const float* mod = (const float*)(p.ws + WS_MOD);

    unsigned* bar_words = (unsigned*)(p.ws + WS_BAR);
    volatile LAS unsigned* bar_st = (volatile LAS unsigned*)(lds + LDS_BYTES - 16);
    if (blockIdx.x == 0) for (int i = threadIdx.x; i < XCD_BAR_WORDS; i += NTHREADS) __hip_atomic_store(bar_words + i, 0u, __ATOMIC_RELAXED, __HIP_MEMORY_SCOPE_AGENT);
    if (threadIdx.x < 2) bar_st[threadIdx.x] = 0u;
    __syncthreads();
    DUP(32, ph_modp(p, lds)); DUP(32, ph_wconv_layer(p, lds, 0)); DUP(32, ph_filt_raw(p, lds, 0));
    grid.sync();
    (void)xcd_barrier_post(bar_words, bar_st);
    ph_modfin(p); DUP(32, ph_filt_norm(p, lds));
    GSYNC();
    for (int l = 0; l < 4; ++l) {
        const int e = l >> 1; const bool even = (l & 1) == 0, colmajor = l >= 2;
        if (l > 0) { DUP(32, ph_wconv_layer(p, lds, l)); if (l == 2) DUP(32, ph_filt_raw(p, lds, 1)); GSYNC(); }
        for (int g = 0; g < NG; ++g) {
            if (even) {
                DUP(16, ph_norm(p, l, 0, true, g, colmajor, (u16*)(p.ws + EV_H))); if (l == 2 && g == 0) DUP(32, ph_filt_norm(p, lds));
                GSYNC();
                { EpiProjEven E; E.projT = (u16*)(p.ws + EV_PROJT); E.projR = (u16*)(p.ws + EV_PROJR); DUP(2, run_gemm(lds, (const u16*)(p.ws + EV_H), (const u16*)(p.ws + WT_IN), MG, EVPAD, 1024, E)); }
                GSYNC();
                DUP(256, ph_mlact(p, e));
                GSYNC();
                DUP(4, ph_mlA(p, lds, e)); DUP(8, ph_hyena(p, lds, e));
                GSYNC();
                ph_mlB(p, e, g); DUP(256, ph_hytrans(p, lds, g));
                GSYNC();
                DUP(4, ph_mlC(p, lds, e, g));
                GSYNC();
                if (g == NG - 1) {
                    { EpiResid E; E.x = p.out; E.mod = mod; E.l = l; E.gidx = 2; E.g = 0; E.colmajor = colmajor; E.grouped = true; E.first = (l == 0); E.xp0 = p.in[I_XP]; E.xs0 = p.in[I_XS]; run_gemm(lds, (const u16*)(p.ws + EV_Y), (const u16*)(p.ws + WT_OUT), 2 * MG, 1024, 1024, E); }
                    GSYNC();
                }
            } else {
                if (g == 0) { DUP(16, ph_norm(p, l, 0, true, g, colmajor, (u16*)(p.ws + OD_H))); GSYNC(); }
                { EpiProjOdd E; E.zd = (u16*)(p.ws + OD_ZD); E.raw = (u16*)(p.ws + OD_RAW); DUP(2, run_gemm(lds, (const u16*)(p.ws + OD_H), (const u16*)(p.ws + WT_IN), MG, ODPAD, 1024, E)); }
                GSYNC();
                DUP(256, ph_ssdact(p, e));
                GSYNC();
                DUP(1, ph_ssdA(p, lds, e, g));
                GSYNC();
                ph_ssdcomb(p, e, g);
                GSYNC();
                DUP(1, ph_ssdB(p, lds, e, g));
                GSYNC();
                ph_ssdfin(p, e);
                GSYNC();
                { EpiResid E; E.x = p.out; E.mod = mod; E.l = l; E.gidx = 2; E.g = g; E.colmajor = colmajor; E.grouped = true; E.first = (l == 0); E.xp0 = p.in[I_XP]; E.xs0 = p.in[I_XS]; run_gemm(lds, (const u16*)(p.ws + OD_YF), (const u16*)(p.ws + WT_OUT), MG, 1024, 2048, E); }
                if (g == 0) { const int nb = (int)gridDim.x, two = (MG / 256) * 4 - nb;
                    if (two > 0 && two < nb) ph_norm(p, l, 0, true, 1, colmajor, (u16*)(p.ws + OD_H), two, nb - two); else ph_norm(p, l, 0, true, 1, colmajor, (u16*)(p.ws + OD_H)); }
                else { const int nb = (int)gridDim.x, two = (MG / 256) * 4 - nb;
                    if (two > 0 && two < nb) ph_norm(p, l, 1, true, 0, false, (u16*)(p.ws + FF_H), two, nb - two, true); else ph_norm(p, l, 1, true, 0, false, (u16*)(p.ws + FF_H), 0, 0, true); }
                GSYNC();
            }
        }
        if (even) { DUP(16, ph_norm(p, l, 1, false, 0, false, (u16*)(p.ws + FF_H))); } else ph_norm(p, l, 1, true, 1, false, (u16*)(p.ws + FF_H), 0, 0, true);
        GSYNC();
        { EpiSwiGLU E; E.uo = (u16*)(p.ws + FF_U); DUP(2, run_gemm(lds, (const u16*)(p.ws + FF_H), (const u16*)(p.ws + WT_F13), NTOK, 2 * FH, 1024, E)); }
        GSYNC();
        { EpiResid E; E.x = p.out; E.mod = mod; E.l = l; E.gidx = 5; E.g = 0; E.colmajor = false; E.grouped = false; E.first = false; E.xp0 = p.in[I_XP]; E.xs0 = p.in[I_XS]; run_gemm(lds, (const u16*)(p.ws + FF_U), (const u16*)(p.ws + WT_F2), NTOK, 1024, FH, E); }
        GSYNC();
    }
    ph_final(p);
}

extern "C" void kernel_launch(void* const* d_in, const int* in_sizes, int n_in, void* d_out, int out_size, void* d_ws, size_t ws_size, hipStream_t stream) {
    static int grid_blocks = 0;
    if (!grid_blocks) {
        int dev = 0, cus = 0, per_cu = 0;
        hipGetDevice(&dev);
        hipDeviceGetAttribute(&cus, hipDeviceAttributeMultiprocessorCount, dev);
        hipFuncSetAttribute((const void*)fwd_megakernel, hipFuncAttributeMaxDynamicSharedMemorySize, LDS_BYTES);
        hipOccupancyMaxActiveBlocksPerMultiprocessor(&per_cu, (const void*)fwd_megakernel, NTHREADS, LDS_BYTES);
        if (per_cu < 1) per_cu = 1;
        grid_blocks = cus * per_cu;
        if (ws_size < 504 * MiB) fprintf(stderr, "kernel_launch: workspace too small: %zu\n", ws_size);
    }
    Params p{};
    for (int i = 0; i < 37; ++i) p.in[i] = (const float*)d_in[i];
    p.out = (float*)d_out; p.ws = (unsigned char*)d_ws;
    void* args[] = {&p};
    hipError_t er = hipLaunchCooperativeKernel((const void*)fwd_megakernel, dim3(grid_blocks), dim3(NTHREADS), args, LDS_BYTES, stream);
    if (er != hipSuccess) fprintf(stderr, "cooperative launch failed: %s (grid %d)\n", hipGetErrorString(er), grid_blocks);
}
```
